# Optimizing an MI355X kernel written in HIP

```python
import jax, jax.numpy as jnp
from jax import lax
import numpy as np

D_MODEL = 1024
BATCH = 8
SEQ = 2048
DEPTH = 4

D_FF = 2816
N_EVEN = (DEPTH + 1) // 2
N_ODD = DEPTH // 2
N_ADA = 9
EPS = 1e-6
NEG_INF = -1e30
Q_BLOCK = 128

CONV_WIDTH = 512
CONV_GROUPS = 8
CONV_TAPS = 3
MLA_HEADS = 8
MLA_NOPE = 64
MLA_ROPE = 32
MLA_V = 64
Q_LORA = 256
KV_LORA = 128
ROPE_THETA = 10000.0
HY_IN = 3 * CONV_WIDTH + Q_LORA + KV_LORA + MLA_ROPE
HY_MIX = CONV_WIDTH + MLA_HEADS * MLA_V
NSA_HEADS = 16
NSA_KV_HEADS = 2
NSA_GROUP = NSA_HEADS // NSA_KV_HEADS
NSA_DK = 64
CMP_BLOCK = 32
CMP_STRIDE = 16
CMP_HID = 128
SLC_BLOCK = 64
N_SEL = 8
WINDOW = 512
FORCE_SCORE = 1e4
NSA_KV_W = 2 * NSA_KV_HEADS * NSA_DK
NSA_IN = NSA_HEADS * NSA_DK + 3 * NSA_KV_W + 3 * NSA_HEADS

kernel_name = "hybrid_conv_mla_nsa_macaron_adaln"


def rms_norm(x, g):
    xf = x.astype(jnp.float32)
    y = xf * lax.rsqrt(jnp.mean(xf * xf, axis=-1, keepdims=True) + EPS)
    return (y * g.astype(jnp.float32)).astype(x.dtype)


def modulate(x, g, shift, scale):
    return rms_norm(x, g) * (1 + scale[:, None]) + shift[:, None]


def swiglu(h, w13, w2):
    a, b = jnp.split(h @ w13, 2, axis=-1)
    return (jax.nn.silu(a) * b) @ w2


def masked_softmax(s, mask):
    s = jnp.where(mask, s.astype(jnp.float32), NEG_INF)
    m = jnp.max(s, axis=-1, keepdims=True)
    p = jnp.exp(s - m) * mask
    return p / jnp.maximum(jnp.sum(p, axis=-1, keepdims=True), 1e-20)


def rope_tables(positions):
    half = MLA_ROPE // 2
    inv = ROPE_THETA ** (-jnp.arange(half, dtype=jnp.float32) / half)
    ang = positions.astype(jnp.float32)[..., None] * inv
    return jnp.cos(ang), jnp.sin(ang)


def apply_rope(t, cos, sin):
    half = t.shape[-1] // 2
    t1 = t[..., :half].astype(jnp.float32)
    t2 = t[..., half:].astype(jnp.float32)
    return jnp.concatenate([t1 * cos - t2 * sin, t1 * sin + t2 * cos], axis=-1).astype(t.dtype)


def to_blocks(t, nqb):
    return jnp.moveaxis(t.reshape(t.shape[0], nqb, Q_BLOCK, *t.shape[2:]), 1, 0)


def from_blocks(o):
    o = jnp.moveaxis(o, 0, 1)
    return o.reshape(o.shape[0], o.shape[1] * o.shape[2], *o.shape[3:])


def short_conv(u, conv_w):
    ch = u.shape[-1]
    return lax.conv_general_dilated(
        u, conv_w[:, None, :], window_strides=(1,), padding=((CONV_TAPS - 1, 0),),
        dimension_numbers=('NWC', 'WIO', 'NWC'), feature_group_count=ch)


def mla_attention(q_nope, q_rope, k_nope, k_rope, v):
    S = q_nope.shape[1]
    nqb = S // Q_BLOCK
    scale = (MLA_NOPE + MLA_ROPE) ** -0.5
    kpos = jnp.arange(S)

    def block(args):
        i, qn, qr = args
        s = (jnp.einsum('bqhd,bkhd->bhqk', qn, k_nope)
             + jnp.einsum('bqhd,bkd->bhqk', qr, k_rope)) * scale
        qpos = i * Q_BLOCK + jnp.arange(Q_BLOCK)
        p = masked_softmax(s, kpos[None, :] <= qpos[:, None])
        return jnp.einsum('bhqk,bkhd->bqhd', p.astype(v.dtype), v)

    o = lax.map(block, (jnp.arange(nqb), to_blocks(q_nope, nqb), to_blocks(q_rope, nqb)))
    return from_blocks(o)


def hybrid_conv_mla(h, cos, sin, w_in, conv_w, q_norm, kv_norm, w_uq, w_ukv, w_out):
    B, S, _ = h.shape
    z = h @ w_in
    cw = CONV_WIDTH
    u, gate_c, gate_b, cq, ckv, kr = jnp.split(
        z, [cw, 2 * cw, 3 * cw, 3 * cw + Q_LORA, 3 * cw + Q_LORA + KV_LORA], axis=-1)
    y_conv = gate_b * short_conv(gate_c * u, conv_w)
    q = (rms_norm(cq, q_norm) @ w_uq).reshape(B, S, MLA_HEADS, MLA_NOPE + MLA_ROPE)
    q_nope, q_rope = q[..., :MLA_NOPE], apply_rope(q[..., MLA_NOPE:], cos[:, :, None], sin[:, :, None])
    kv = (rms_norm(ckv, kv_norm) @ w_ukv).reshape(B, S, MLA_HEADS, MLA_NOPE + MLA_V)
    k_nope, v = kv[..., :MLA_NOPE], kv[..., MLA_NOPE:]
    k_rope = apply_rope(kr, cos, sin)
    y_att = mla_attention(q_nope, q_rope, k_nope, k_rope, v).reshape(B, S, MLA_HEADS * MLA_V)
    return jnp.concatenate([y_conv, y_att], axis=-1) @ w_out


def nsa_attention(h, w_in, cmp_pe, cmp_w1, cmp_w2, gate_b, w_out):
    B, S, _ = h.shape
    G, R, DK = NSA_KV_HEADS, NSA_GROUP, NSA_DK
    dt = h.dtype
    z = h @ w_in
    qd = NSA_HEADS * DK
    q, kv_c, kv_s, kv_w, g = jnp.split(
        z, [qd, qd + NSA_KV_W, qd + 2 * NSA_KV_W, qd + 3 * NSA_KV_W], axis=-1)
    q = q.reshape(B, S, G, R, DK)
    gates = jax.nn.sigmoid(g + gate_b).reshape(B, S, G, R, 3)
    kv_c = kv_c.reshape(B, S, 2, G, DK)
    kv_s = kv_s.reshape(B, S, 2, G, DK)
    kv_w = kv_w.reshape(B, S, 2, G, DK)

    nc = (S - CMP_BLOCK) // CMP_STRIDE + 1
    cidx = jnp.arange(nc)[:, None] * CMP_STRIDE + jnp.arange(CMP_BLOCK)[None, :]

    def compress(t, pe, w1, w2):
        blk = t[:, cidx] + pe[:, None, :]
        blk = jnp.moveaxis(blk, 3, 2).reshape(B, nc, G, CMP_BLOCK * DK)
        return jax.nn.silu(blk @ w1) @ w2

    k_cmp = compress(kv_c[:, :, 0], cmp_pe[0], cmp_w1[0], cmp_w2[0])
    v_cmp = compress(kv_c[:, :, 1], cmp_pe[1], cmp_w1[1], cmp_w2[1])
    cmp_end = jnp.arange(nc) * CMP_STRIDE + CMP_BLOCK - 1

    ns = S // SLC_BLOCK
    n_sel = min(N_SEL, ns)
    cs = jnp.arange(nc)[:, None] * CMP_STRIDE
    ss = jnp.arange(ns)[None, :] * SLC_BLOCK
    overlap = jnp.clip(jnp.minimum(cs + CMP_BLOCK, ss + SLC_BLOCK) - jnp.maximum(cs, ss), 0, None)
    agg = overlap.astype(jnp.float32) / CMP_BLOCK
    blk_idx = jnp.arange(ns)
    k_slc = kv_s[:, :, 0].reshape(B, ns, SLC_BLOCK, G, DK).transpose(0, 3, 1, 2, 4)
    v_slc = kv_s[:, :, 1].reshape(B, ns, SLC_BLOCK, G, DK).transpose(0, 3, 1, 2, 4)
    bi = jnp.arange(B)[:, None, None, None]
    gi = jnp.arange(G)[None, :, None, None]

    pad = ((0, 0), (WINDOW, 0), (0, 0), (0, 0))
    k_win = jnp.pad(kv_w[:, :, 0], pad)
    v_win = jnp.pad(kv_w[:, :, 1], pad)
    scale = DK ** -0.5
    nqb = S // Q_BLOCK

    def block(args):
        i, qb, gb = args
        t = i * Q_BLOCK + jnp.arange(Q_BLOCK)
        s_c = jnp.einsum('bqgrd,bngd->bgrqn', qb, k_cmp) * scale
        p_c = masked_softmax(s_c, cmp_end[None, :] <= t[:, None])
        o_c = jnp.einsum('bgrqn,bngd->bqgrd', p_c.astype(dt), v_cmp)
        imp = jnp.einsum('bgrqn,nj->bgqj', p_c, agg)
        cur = t // SLC_BLOCK
        forced = ((blk_idx[None, :] == 0) | (blk_idx[None, :] == cur[:, None])
                  | (blk_idx[None, :] == cur[:, None] - 1))
        causal_blk = blk_idx[None, :] * SLC_BLOCK <= t[:, None]
        imp = jnp.where(forced, FORCE_SCORE, jnp.where(causal_blk, imp, NEG_INF))
        _, sel = lax.top_k(imp, n_sel)
        ks = k_slc[bi, gi, sel].reshape(B, G, Q_BLOCK, n_sel * SLC_BLOCK, DK)
        vs = v_slc[bi, gi, sel].reshape(B, G, Q_BLOCK, n_sel * SLC_BLOCK, DK)
        kpos_s = (sel[..., None] * SLC_BLOCK + jnp.arange(SLC_BLOCK)).reshape(B, G, Q_BLOCK, -1)
        s_s = jnp.einsum('bqgrd,bgqkd->bgrqk', qb, ks) * scale
        p_s = masked_softmax(s_s, kpos_s[:, :, None] <= t[:, None])
        o_s = jnp.einsum('bgrqk,bgqkd->bqgrd', p_s.astype(dt), vs)
        kw = lax.dynamic_slice_in_dim(k_win, i * Q_BLOCK, WINDOW + Q_BLOCK, axis=1)
        vw = lax.dynamic_slice_in_dim(v_win, i * Q_BLOCK, WINDOW + Q_BLOCK, axis=1)
        kpos_w = i * Q_BLOCK - WINDOW + jnp.arange(WINDOW + Q_BLOCK)
        mask_w = ((kpos_w[None, :] <= t[:, None]) & (kpos_w[None, :] > t[:, None] - WINDOW)
                  & (kpos_w[None, :] >= 0))
        s_w = jnp.einsum('bqgrd,bkgd->bgrqk', qb, kw) * scale
        p_w = masked_softmax(s_w, mask_w)
        o_w = jnp.einsum('bgrqk,bkgd->bqgrd', p_w.astype(dt), vw)
        return gb[..., 0:1] * o_c + gb[..., 1:2] * o_s + gb[..., 2:3] * o_w

    o = lax.map(block, (jnp.arange(nqb), to_blocks(q, nqb), to_blocks(gates, nqb)))
    return from_blocks(o).reshape(B, S, NSA_HEADS * DK) @ w_out


def setup_inputs(seed: int = 0) -> dict:
    key = jax.random.key(seed)
    ks = jax.random.split(key, 24)
    nrm = lambda k, shape, s: jax.random.normal(k, shape, jnp.float32) * s
    D = D_MODEL
    return {
        "x": nrm(ks[0], (BATCH, SEQ, D), 1.0),
        "c": nrm(ks[1], (BATCH, D), 1.0),
        "positions": (jnp.arange(SEQ, dtype=jnp.int32)[None, :]
                      + jax.random.randint(ks[2], (BATCH, 1), 0, 1024, dtype=jnp.int32)),
        "ada_w": nrm(ks[3], (DEPTH, D, N_ADA * D), 0.5 * D ** -0.5),
        "ada_b": nrm(ks[4], (DEPTH, N_ADA * D), 0.02),
        "norm_g": 1.0 + nrm(ks[5], (DEPTH, 3, D), 0.02),
        "final_g": 1.0 + nrm(ks[6], (D,), 0.02),
        "ff_w13": nrm(ks[7], (DEPTH, 2, D, 2 * D_FF), D ** -0.5),
        "ff_w2": nrm(ks[8], (DEPTH, 2, D_FF, D), D_FF ** -0.5),
        "hy_w_in": nrm(ks[9], (N_EVEN, D, HY_IN), D ** -0.5),
        "hy_conv_w": nrm(ks[10], (N_EVEN, CONV_TAPS, CONV_WIDTH), CONV_TAPS ** -0.5),
        "hy_q_norm": 1.0 + nrm(ks[11], (N_EVEN, Q_LORA), 0.02),
        "hy_kv_norm": 1.0 + nrm(ks[12], (N_EVEN, KV_LORA), 0.02),
        "hy_w_uq": nrm(ks[13], (N_EVEN, Q_LORA, MLA_HEADS * (MLA_NOPE + MLA_ROPE)), Q_LORA ** -0.5),
        "hy_w_ukv": nrm(ks[14], (N_EVEN, KV_LORA, MLA_HEADS * (MLA_NOPE + MLA_V)), KV_LORA ** -0.5),
        "hy_w_out": nrm(ks[15], (N_EVEN, HY_MIX, D), HY_MIX ** -0.5),
        "nsa_w_in": nrm(ks[16], (N_ODD, D, NSA_IN), D ** -0.5),
        "nsa_cmp_pe": nrm(ks[17], (N_ODD, 2, CMP_BLOCK, NSA_DK), 0.1),
        "nsa_cmp_w1": nrm(ks[18], (N_ODD, 2, CMP_BLOCK * NSA_DK, CMP_HID), (CMP_BLOCK * NSA_DK) ** -0.5),
        "nsa_cmp_w2": nrm(ks[19], (N_ODD, 2, CMP_HID, NSA_DK), CMP_HID ** -0.5),
        "nsa_gate_b": nrm(ks[20], (N_ODD, 3 * NSA_HEADS), 0.1),
        "nsa_w_out": nrm(ks[21], (N_ODD, NSA_HEADS * NSA_DK, D), (NSA_HEADS * NSA_DK) ** -0.5),
    }


def reference(x, c, positions, ada_w, ada_b, norm_g, final_g, ff_w13, ff_w2,
              hy_w_in, hy_conv_w, hy_q_norm, hy_kv_norm, hy_w_uq, hy_w_ukv, hy_w_out,
              nsa_w_in, nsa_cmp_pe, nsa_cmp_w1, nsa_cmp_w2, nsa_gate_b, nsa_w_out):
    cos, sin = rope_tables(positions)
    c_act = jax.nn.silu(c)
    for l in range(DEPTH):
        mod = c_act @ ada_w[l] + ada_b[l]
        sh1, sc1, g1, sh2, sc2, g2, sh3, sc3, g3 = jnp.split(mod, N_ADA, axis=-1)
        h = modulate(x, norm_g[l, 0], sh1, sc1)
        x = x + 0.5 * g1[:, None] * swiglu(h, ff_w13[l, 0], ff_w2[l, 0])
        h = modulate(x, norm_g[l, 1], sh2, sc2)
        m = l // 2
        if l % 2 == 0:
            y = hybrid_conv_mla(h, cos, sin, hy_w_in[m], hy_conv_w[m], hy_q_norm[m],
                                hy_kv_norm[m], hy_w_uq[m], hy_w_ukv[m], hy_w_out[m])
        else:
            y = nsa_attention(h, nsa_w_in[m], nsa_cmp_pe[m], nsa_cmp_w1[m], nsa_cmp_w2[m],
                              nsa_gate_b[m], nsa_w_out[m])
        x = x + g2[:, None] * y
        h = modulate(x, norm_g[l, 2], sh3, sc3)
        x = x + 0.5 * g3[:, None] * swiglu(h, ff_w13[l, 1], ff_w2[l, 1])
    return rms_norm(x, final_g)
```

```cpp
#include <hip/hip_runtime.h>
#include <hip/hip_cooperative_groups.h>
#include <cstdio>
#include <cstdint>
namespace cg = cooperative_groups;
namespace pg8 {
#define PG8_LAS __attribute__((address_space(3)))
typedef unsigned short bf16_t;
typedef short bf16x8 __attribute__((ext_vector_type(8)));
typedef float f32x4 __attribute__((ext_vector_type(4)));
typedef unsigned u32x4 __attribute__((ext_vector_type(4)));
constexpr int BM = 256, BK = 64, HALF = 128, HTB = HALF * BK * 2  , STAGE_BYTES = 8 * HTB, NXCD = 8, WGM = 8;

__host__ __device__ __forceinline__ int lds_byte(int r, int c) { const int st = (r >> 4) * 2 + (c >> 5), rr = r & 15, cc = c & 31, ob = rr * 64 + cc * 2; return st * 1024 + (ob ^ (((ob >> 9) & 1) << 5)); }
__host__ __device__ __forceinline__ void stage_rc(int b, int& R, int& C) { const int st = b / 1024, sb = b % 1024, swz = sb ^ (((sb >> 9) & 1) << 5); R = (st >> 1) * 16 + swz / 64; C = (st & 1) * 32 + (swz % 64) / 2; }
__host__ __device__ __forceinline__ int perm32(int rho) { const int n = rho >> 4, i = rho & 15; return 8 * (i >> 2) + 4 * n + (i & 3); }

struct Unit { int pm, pn; };
struct Gemm { const bf16_t* A; const bf16_t* Bt; int M, N, K, lda, ldb; };

struct StaticOrder {
    int nM, nN, nwg, G, c;
    __host__ __device__ void init(int M, int N, int G_, int c_) { nM = M / BM; nN = N / BM; nwg = nM * nN; G = G_; c = c_; }
    __host__ __device__ bool next(int i, Unit& u) const {
        const long L = (long)i * G + c; if (L >= nwg) return false;
        int wgid = (int)L; { const int q = nwg / NXCD, r = nwg % NXCD, xcd = wgid % NXCD, off = wgid / NXCD; wgid = (xcd < r ? xcd * (q + 1) : r * (q + 1) + (xcd - r) * q) + off; }
        const int nig = WGM * nN, gid = wgid / nig, fm = gid * WGM, gsz = (nM - fm) < WGM ? (nM - fm) : WGM;
        u.pm = fm + ((wgid % nig) % gsz); u.pn = (wgid % nig) / gsz; return true;
    }
    __device__ __forceinline__ void a_ready(const Unit&) const {}
    __device__ __forceinline__ void done(const Unit&) const {}
};

__device__ __forceinline__ unsigned cvt_pk_bf16(float lo, float hi) { unsigned r; asm volatile("v_cvt_pk_bf16_f32 %0, %1, %2" : "=v"(r) : "v"(lo), "v"(hi)); return r; }

template <class Epi, class Sched, bool ALIGN_EPI = false, bool SP2 = false>
__device__ __forceinline__ void gemm_phase(PG8_LAS unsigned char* lds, const Gemm g, const Sched& S, const Epi& E) {
    int tid_ = threadIdx.x; asm volatile("" : "+v"(tid_));
    const int tid = tid_, wid = __builtin_amdgcn_readfirstlane(tid >> 6), lane = tid & 63, wr = wid >> 2, wc = wid & 3, fr = lane & 15, fq = lane >> 4;
    const int K = g.K, nt = K / BK;
    unsigned voffA[2], voffB[2];
#pragma unroll
    for (int i = 0; i < 2; ++i) { int R, C; stage_rc(tid * 16 + i * 8192, R, C); const int Rb = Epi::PERM ? ((R & ~31) + perm32(R & 31)) : R;
        voffA[i] = (unsigned)(R * g.lda + C) * 2u; voffB[i] = (unsigned)(Rb * g.ldb + C) * 2u; }
    const size_t kstep = (size_t)(BK * 2);
    const size_t hstep = (size_t)HALF * g.ldb * 2;
    const size_t tstep = 2 * hstep; const size_t hstepA = (size_t)HALF * g.lda * 2; const size_t tstepA = 2 * hstepA;
    const unsigned ldsw = (unsigned)wid * 1024u;
    const int aoff = lds_byte(wr * 64 + fr, fq * 8), boff = lds_byte(wc * 32 + fr, fq * 8);
#define PG8_SA(b, h) (((b) * 2 + (h)) * HTB)
#define PG8_SB(b, h) ((4 + (b) * 2 + (h)) * HTB)
#define PG8_STAGE(bufoff, gbase, voff) do { _Pragma("unroll") for (int _i = 0; _i < 2; ++_i) \
        __builtin_amdgcn_global_load_lds((const unsigned*)((const char*)(gbase) + (voff)[_i]), (PG8_LAS unsigned*)(lds + (bufoff) + ldsw + _i * 8192), 16, 0, 0); } while (0)
#define PG8_LDA(dst, b, h) do { _Pragma("unroll") for (int m = 0; m < 4; ++m) _Pragma("unroll") for (int k = 0; k < 2; ++k) dst[m][k] = *(const PG8_LAS bf16x8*)(lds + PG8_SA(b, h) + aoff + m * 2048 + k * 1024); } while (0)
#define PG8_LDB(dst, b, h) do { _Pragma("unroll") for (int n = 0; n < 2; ++n) _Pragma("unroll") for (int k = 0; k < 2; ++k) dst[n][k] = *(const PG8_LAS bf16x8*)(lds + PG8_SB(b, h) + boff + n * 2048 + k * 1024); } while (0)
#define PG8_MMA(ai, bj, At, Bt) do { __builtin_amdgcn_s_setprio(1); _Pragma("unroll") for (int m = 0; m < 4; ++m) _Pragma("unroll") for (int n = 0; n < 2; ++n) _Pragma("unroll") for (int k = 0; k < 2; ++k) \
        acc[ai][bj][m][n] = __builtin_amdgcn_mfma_f32_16x16x32_bf16(Bt[n][k], At[m][k], acc[ai][bj][m][n], 0, 0, 0); __builtin_amdgcn_s_setprio(0); } while (0)
#define PG8_WAIT_V(n) asm volatile("s_waitcnt vmcnt(" #n ")" ::: "memory")
#define PG8_WAIT_L(n) asm volatile("s_waitcnt lgkmcnt(" #n ")" ::: "memory")
#define PG8_BAR __builtin_amdgcn_s_barrier()
#define PG8_SCHED __builtin_amdgcn_sched_barrier(0)
    Unit cur, nxt; int ui = 0;
    if (!S.next(0, cur)) return;
    f32x4 acc[2][2][4][2];
#pragma unroll
    for (int a = 0; a < 2; ++a)
#pragma unroll
        for (int b = 0; b < 2; ++b)
#pragma unroll
            for (int m = 0; m < 4; ++m)
#pragma unroll
                for (int n = 0; n < 2; ++n) acc[a][b][m][n] = (f32x4){0.f, 0.f, 0.f, 0.f};
    bf16x8 At[4][2], B0[2][2], B1[2][2];
    const char* cA = (const char*)g.A + (size_t)cur.pm * tstepA; const char* cB = (const char*)g.Bt + (size_t)cur.pn * tstep;
    S.a_ready(cur);
    if constexpr (SP2) {
        PG8_STAGE(PG8_SB(0, 0), cB, voffB); PG8_STAGE(PG8_SB(0, 1), cB + hstep, voffB); PG8_STAGE(PG8_SA(0, 0), cA, voffA); PG8_STAGE(PG8_SA(0, 1), cA + hstepA, voffA);
        if (wr == 1) PG8_BAR;
        PG8_WAIT_V(2); PG8_BAR;
        PG8_STAGE(PG8_SB(1, 0), cB + kstep, voffB); PG8_STAGE(PG8_SA(1, 0), cA + kstep, voffA); PG8_STAGE(PG8_SB(1, 1), cB + hstep + kstep, voffB);
        PG8_WAIT_V(6); PG8_BAR;
    } else {
        PG8_STAGE(PG8_SB(0, 0), cB, voffB); PG8_STAGE(PG8_SA(0, 0), cA, voffA); PG8_STAGE(PG8_SB(0, 1), cB + hstep, voffB); PG8_STAGE(PG8_SA(0, 1), cA + hstepA, voffA);
        if (wr == 1) PG8_BAR;
        PG8_WAIT_V(4); PG8_BAR;
        PG8_STAGE(PG8_SB(1, 0), cB + kstep, voffB); PG8_STAGE(PG8_SA(1, 0), cA + kstep, voffA); PG8_STAGE(PG8_SB(1, 1), cB + hstep + kstep, voffB);
        PG8_WAIT_V(6); PG8_BAR;
    }
    for (;;) {
        const bool has_next = S.next(ui + 1, nxt);
        const char* nA = has_next ? (const char*)g.A + (size_t)nxt.pm * tstepA : cA; const char* nB = has_next ? (const char*)g.Bt + (size_t)nxt.pn * tstep : cB;
        for (int t = 0; t < nt; t += 2) {
            const bool last = (t == nt - 2);
            const char* a1 = cA + (size_t)(t + 1) * kstep;
            const char* a2 = last ? nA : cA + (size_t)(t + 2) * kstep; const char* b2 = last ? nB : cB + (size_t)(t + 2) * kstep;
            const char* a3 = a2 + kstep; const char* b3 = b2 + kstep;
            if (last && has_next) S.a_ready(nxt);
            if constexpr (SP2) {
            PG8_LDB(B0, 0, 0); PG8_LDB(B1, 0, 1); PG8_SCHED; PG8_LDA(At, 0, 0); PG8_STAGE(PG8_SA(1, 1), a1 + hstepA, voffA);
            PG8_WAIT_V(8); PG8_WAIT_L(0); PG8_BAR; PG8_MMA(0, 0, At, B0); PG8_MMA(0, 1, At, B1); PG8_BAR; PG8_SCHED;
            PG8_LDA(At, 0, 1); PG8_STAGE(PG8_SB(0, 0), b2, voffB); PG8_STAGE(PG8_SB(0, 1), b2 + hstep, voffB); PG8_STAGE(PG8_SA(0, 0), a2, voffA);
            PG8_WAIT_V(8); PG8_WAIT_L(0); PG8_BAR; PG8_MMA(1, 0, At, B0); PG8_MMA(1, 1, At, B1); PG8_BAR; PG8_SCHED;
            PG8_LDB(B0, 1, 0); PG8_LDB(B1, 1, 1); PG8_SCHED; PG8_LDA(At, 1, 0); PG8_STAGE(PG8_SA(0, 1), a2 + hstepA, voffA);
            PG8_WAIT_V(8); PG8_WAIT_L(0); PG8_BAR; PG8_MMA(0, 0, At, B0); PG8_MMA(0, 1, At, B1); PG8_BAR; PG8_SCHED;
            PG8_LDA(At, 1, 1); PG8_STAGE(PG8_SB(1, 0), b3, voffB); PG8_STAGE(PG8_SB(1, 1), b3 + hstep, voffB); PG8_STAGE(PG8_SA(1, 0), a3, voffA);
            PG8_WAIT_V(8); PG8_WAIT_L(0); PG8_BAR; PG8_MMA(1, 0, At, B0); PG8_MMA(1, 1, At, B1); PG8_BAR; PG8_SCHED;
            } else {
            PG8_LDB(B0, 0, 0); PG8_SCHED; PG8_LDA(At, 0, 0); PG8_STAGE(PG8_SA(1, 1), a1 + hstepA, voffA);
            PG8_WAIT_L(8); PG8_BAR; PG8_WAIT_L(0); PG8_MMA(0, 0, At, B0); PG8_BAR; PG8_SCHED;
            PG8_LDB(B1, 0, 1); PG8_STAGE(PG8_SB(0, 0), b2, voffB);
            PG8_BAR; PG8_WAIT_L(0); PG8_MMA(0, 1, At, B1); PG8_BAR;
            PG8_LDA(At, 0, 1); PG8_STAGE(PG8_SA(0, 0), a2, voffA);
            PG8_BAR; PG8_WAIT_L(0); PG8_MMA(1, 0, At, B0); PG8_BAR; PG8_SCHED;
            PG8_STAGE(PG8_SB(0, 1), b2 + hstep, voffB);
            PG8_WAIT_V(6); PG8_BAR; PG8_MMA(1, 1, At, B1); PG8_BAR;
            PG8_LDB(B0, 1, 0); PG8_SCHED; PG8_LDA(At, 1, 0); PG8_STAGE(PG8_SA(0, 1), a2 + hstepA, voffA);
            PG8_WAIT_L(8); PG8_BAR; PG8_WAIT_L(0); PG8_MMA(0, 0, At, B0); PG8_BAR; PG8_SCHED;
            PG8_LDB(B1, 1, 1); PG8_STAGE(PG8_SB(1, 0), b3, voffB);
            PG8_BAR; PG8_WAIT_L(0); PG8_MMA(0, 1, At, B1); PG8_BAR;
            PG8_LDA(At, 1, 1); PG8_STAGE(PG8_SA(1, 0), a3, voffA);
            PG8_BAR; PG8_WAIT_L(0); PG8_MMA(1, 0, At, B0); PG8_BAR; PG8_SCHED;
            PG8_STAGE(PG8_SB(1, 1), b3 + hstep, voffB);
            PG8_WAIT_V(6); PG8_BAR; PG8_MMA(1, 1, At, B1); PG8_BAR;
            }
        }
        if constexpr (ALIGN_EPI) { if (wr == 0) PG8_BAR; }
        if constexpr (!Epi::AFTER_DRAIN) { E(acc, cur, wr, wc, fr, fq); S.done(cur); }
        if (!has_next) break;
#pragma unroll
        for (int a = 0; a < 2; ++a)
#pragma unroll
            for (int b = 0; b < 2; ++b)
#pragma unroll
                for (int m = 0; m < 4; ++m)
#pragma unroll
                    for (int n = 0; n < 2; ++n) acc[a][b][m][n] = (f32x4){0.f, 0.f, 0.f, 0.f};
        cur = nxt; cA = nA; cB = nB; ++ui;
        if constexpr (ALIGN_EPI) { if (wr == 1) PG8_BAR; }
    }
    PG8_WAIT_V(0);
    if constexpr (!ALIGN_EPI) { if (wr == 0) PG8_BAR; }
    PG8_BAR;
    if constexpr (Epi::AFTER_DRAIN) { E.fused(acc, cur, wr, wc, fr, fq, lds, wid, lane); S.done(cur); }
#undef PG8_SA
#undef PG8_SB
#undef PG8_STAGE
#undef PG8_LDA
#undef PG8_LDB
#undef PG8_MMA
#undef PG8_WAIT_V
#undef PG8_WAIT_L
#undef PG8_BAR
#undef PG8_SCHED
}
}


#define DI __device__ __forceinline__
#define LAS __attribute__((address_space(3)))
using pg8::bf16_t; using pg8::bf16x8; using pg8::f32x4; using pg8::u32x4; using pg8::cvt_pk_bf16;
typedef short bf16x4 __attribute__((ext_vector_type(4)));
typedef unsigned u32x2 __attribute__((ext_vector_type(2)));

constexpr int NB = 8, SEQ = 2048, T = NB * SEQ, D = 1024, DFF = 2816, NLAYER = 4, NMOD = 9 * D;
constexpr int HY_IN = 1952, NSA_IN = 1840;
constexpr float EPS = 1e-6f;
constexpr float LOG2E = 1.4426950408889634f;
constexpr int LDS_BYTES = 147456;

constexpr size_t al256(size_t x) { return (x + 255) & ~(size_t)255; }
constexpr size_t WS_MOD   = 0;
constexpr size_t MOD_BYTES = (size_t)NLAYER * NB * NMOD * 4;
constexpr size_t WS_BAR   = WS_MOD + al256(MOD_BYTES);
constexpr size_t BAR_BYTES = 16384;
constexpr size_t ZERO_BYTES = al256(MOD_BYTES) + BAR_BYTES;
constexpr size_t WS_ROPE  = WS_BAR + BAR_BYTES;
constexpr size_t WS_CBIAS = WS_ROPE + al256((size_t)2 * T * 16 * 4);
constexpr size_t WS_WT13  = WS_CBIAS + al256(4 * 16 * 128 * 4);
constexpr size_t WS_WT2   = WS_WT13 + al256((size_t)8 * 5632 * 1024 * 2);
constexpr size_t WS_WTHI  = WS_WT2 + al256((size_t)8 * 1024 * 2816 * 2);
constexpr size_t WS_WTUQ  = WS_WTHI + al256((size_t)2 * 2048 * 1024 * 2);
constexpr size_t WS_WTUKV = WS_WTUQ + al256((size_t)2 * 768 * 256 * 2);
constexpr size_t WS_WTHO  = WS_WTUKV + al256((size_t)2 * 1024 * 128 * 2);
constexpr size_t WS_WTNI  = WS_WTHO + al256((size_t)2 * 1024 * 1024 * 2);
constexpr size_t WS_WTNO  = WS_WTNI + al256((size_t)2 * 2048 * 1024 * 2);
constexpr size_t WS_WTC1  = WS_WTNO + al256((size_t)2 * 1024 * 1024 * 2);
constexpr size_t WS_X     = WS_WTC1 + al256((size_t)4 * 256 * 2048 * 2);
constexpr size_t WS_HB    = WS_X + al256((size_t)T * D * 4);
constexpr size_t WS_UB    = WS_HB + al256((size_t)T * D * 2);
constexpr size_t WS_Z     = WS_UB + al256((size_t)T * DFF * 2);
constexpr size_t WS_CQ    = WS_Z + al256((size_t)T * 2048 * 2);
constexpr size_t WS_CKV   = WS_CQ + al256((size_t)T * 256 * 2);
constexpr size_t WS_QB    = WS_CKV + al256((size_t)T * 128 * 2);
constexpr size_t WS_KB    = WS_QB + al256((size_t)T * 1024 * 2);
constexpr size_t WS_VT    = WS_KB + al256((size_t)T * 768 * 2);
constexpr size_t WS_YB    = WS_VT + al256((size_t)T * 512 * 2);
constexpr size_t WS_KVC   = WS_YB + al256((size_t)T * 1024 * 2);
constexpr size_t WS_KS    = WS_KVC + al256((size_t)T * 256 * 2 + 8192);
constexpr size_t WS_VTS   = WS_KS + al256((size_t)T * 128 * 2);
constexpr size_t WS_KW    = WS_VTS + al256((size_t)T * 128 * 2);
constexpr size_t WS_VTW   = WS_KW + al256((size_t)T * 128 * 2);
constexpr size_t WS_GT    = WS_VTW + al256((size_t)T * 128 * 2);
constexpr size_t WS_CH    = WS_GT + al256((size_t)T * 48 * 4);
constexpr size_t WS_KC    = WS_CH + al256((size_t)16 * 2048 * 128 * 4);
constexpr size_t WS_VTC   = WS_KC + al256((size_t)16 * 128 * 64 * 2);
constexpr size_t WS_YF    = WS_VTC + al256((size_t)16 * 64 * 128 * 2);
constexpr size_t WS_END   = WS_YF + al256((size_t)T * 1024 * 4);

struct Params {
  const float* x; const float* c; const int* positions; const float* ada_w; const float* ada_b; const float* norm_g; const float* final_g;
  const float* ff_w13; const float* ff_w2; const float* hy_w_in; const float* hy_conv_w; const float* hy_q_norm; const float* hy_kv_norm;
  const float* hy_w_uq; const float* hy_w_ukv; const float* hy_w_out; const float* nsa_w_in; const float* nsa_cmp_pe; const float* nsa_cmp_w1;
  const float* nsa_cmp_w2; const float* nsa_gate_b; const float* nsa_w_out; float* out; unsigned char* ws;
};

DI int otid() { int t = threadIdx.x; asm volatile("" : "+v"(t)); return t; }
DI float wave_sum(float v) { v += __shfl_xor(v, 32); v += __shfl_xor(v, 16); v += __shfl_xor(v, 8); v += __shfl_xor(v, 4); v += __shfl_xor(v, 2); v += __shfl_xor(v, 1); return v; }
DI float bf2f(bf16_t h) { return __uint_as_float((unsigned)h << 16); }
DI float bflo(unsigned w) { return __uint_as_float(w << 16); }
DI float bfhi(unsigned w) { return __uint_as_float(w & 0xffff0000u); }
DI float fast_exp2(float x) { return __builtin_amdgcn_exp2f(x); }
DI float sigmoidf_(float x) { return __builtin_amdgcn_rcpf(1.f + __expf(-x)); }
DI float siluf_(float x) { return x * __builtin_amdgcn_rcpf(1.f + __expf(-x)); }
#define MFMA16(a, b, c) __builtin_amdgcn_mfma_f32_16x16x32_bf16((a), (b), (c), 0, 0, 0)

template <int MODE> DI int map_col(int n, int Nsrc) {
  if (MODE == 0) return n < Nsrc ? n : -1;
  if (MODE == 1) return ((n & 255) >> 7) * DFF + (n >> 8) * 128 + (n & 127);
  const int hh = n / 96, jj = n - hh * 96;
  return jj < 64 ? n : hh * 96 + 64 + ((jj - 64) & 1) * 16 + ((jj - 64) >> 1);
}
template <int MODE, int KT, bool VEC> DI void prep_transpose(const float* __restrict__ src, int K, int Nsrc, bf16_t* __restrict__ dst, int Ndst, LAS float* tile, int& rot, int Gp = 0, int bidp = 0) {
  const int G = Gp ? Gp : (int)gridDim.x, tid = otid();
  const int ntk = K / KT, nt = (Ndst >> 6) * ntk;
  int first = (Gp ? bidp : (int)blockIdx.x) - rot; if (first < 0) first += G;
  if (VEC) {
    const int c4 = tid & 15, kr = tid >> 4;
    float4 v[KT / 32];
#define PT_LOAD(tt) do { const int tn_ = (tt) / ntk, tk_ = (tt) - tn_ * ntk; const int sc_ = map_col<MODE>(tn_ * 64 + c4 * 4, Nsrc); \
      _Pragma("unroll") for (int p = 0; p < KT / 32; ++p) v[p] = sc_ >= 0 ? *(const float4*)(src + (size_t)(tk_ * KT + p * 32 + kr) * Nsrc + sc_) : make_float4(0.f, 0.f, 0.f, 0.f); } while (0)
    if (first < nt) PT_LOAD(first);
    for (int t = first; t < nt; t += G) {
      const int tn = t / ntk, tk = t - tn * ntk, n0 = tn * 64, k0 = tk * KT;
#pragma unroll
      for (int p = 0; p < KT / 32; ++p) { LAS float* tp = tile + (p * 32 + kr) * 65 + c4 * 4; tp[0] = v[p].x; tp[1] = v[p].y; tp[2] = v[p].z; tp[3] = v[p].w; }
      __syncthreads();
      if (t + G < nt) PT_LOAD(t + G);
#pragma unroll
      for (int q = 0; q < KT / 64; ++q) {
        const int n = tid >> 3, kc = (tid & 7) + q * 8; float w8[8];
#pragma unroll
        for (int j = 0; j < 8; ++j) w8[j] = tile[(kc * 8 + j) * 65 + n];
        u32x4 w; w.x = cvt_pk_bf16(w8[0], w8[1]); w.y = cvt_pk_bf16(w8[2], w8[3]); w.z = cvt_pk_bf16(w8[4], w8[5]); w.w = cvt_pk_bf16(w8[6], w8[7]);
        *(u32x4*)(dst + (size_t)(n0 + n) * K + k0 + kc * 8) = w;
      }
      __syncthreads();
    }
#undef PT_LOAD
  } else {
  for (int t = first; t < nt; t += G) {
    const int tn = t / ntk, tk = t - tn * ntk, n0 = tn * 64, k0 = tk * KT;
    {
      const int kr = tid >> 6, nn = tid & 63; const int sc = map_col<MODE>(n0 + nn, Nsrc);
      float v[KT / 8];
#pragma unroll
      for (int p = 0; p < KT / 8; ++p) v[p] = sc >= 0 ? src[(size_t)(k0 + p * 8 + kr) * Nsrc + sc] : 0.f;
#pragma unroll
      for (int p = 0; p < KT / 8; ++p) tile[(p * 8 + kr) * 65 + nn] = v[p];
    }
    __syncthreads();
#pragma unroll
    for (int q = 0; q < KT / 64; ++q) {
      const int n = tid >> 3, kc = (tid & 7) + q * 8; float v[8];
#pragma unroll
      for (int j = 0; j < 8; ++j) v[j] = tile[(kc * 8 + j) * 65 + n];
      u32x4 w; w.x = cvt_pk_bf16(v[0], v[1]); w.y = cvt_pk_bf16(v[2], v[3]); w.z = cvt_pk_bf16(v[4], v[5]); w.w = cvt_pk_bf16(v[6], v[7]);
      *(u32x4*)(dst + (size_t)(n0 + n) * K + k0 + kc * 8) = w;
    }
    __syncthreads();
  }
  }
  rot = (rot + nt) % G;
}

DI void prep_adaln(const float* __restrict__ cvec, const float* __restrict__ ada_w, const float* __restrict__ ada_b, float* mod, LAS float* lbuf) {
  const int tid = otid();
  LAS float* cact = lbuf;
  LAS float* red = lbuf + 8 * 1024;
  for (int i = tid; i < 8 * 1024; i += 512) cact[i] = siluf_(cvec[i]);
  __syncthreads();
  const int col = tid & 31, kc = tid >> 5;
  for (int item = blockIdx.x; item < NLAYER * 288; item += gridDim.x) {
    const int l = item / 288, nc = item - l * 288;
    const int n = nc * 32 + col;
    float acc[8];
#pragma unroll
    for (int b = 0; b < 8; ++b) acc[b] = 0.f;
    const float* w = ada_w + ((size_t)l * D + kc * 64) * NMOD + n;
    for (int k0 = 0; k0 < 64; k0 += 32) {
      float wv[32];
#pragma unroll
      for (int k = 0; k < 32; ++k) wv[k] = w[(size_t)(k0 + k) * NMOD];
#pragma unroll
      for (int k = 0; k < 32; ++k)
#pragma unroll
        for (int b = 0; b < 8; ++b) acc[b] += cact[b * 1024 + kc * 64 + k0 + k] * wv[k];
    }
#pragma unroll
    for (int b = 0; b < 8; ++b) red[(kc * 8 + b) * 32 + col] = acc[b];
    __syncthreads();
    if (tid < 256) { const int b = tid >> 5; float s = ada_b[l * NMOD + n];
#pragma unroll
      for (int q = 0; q < 16; ++q) s += red[(q * 8 + b) * 32 + col];
      mod[(size_t)(l * NB + b) * NMOD + n] = s; }
    __syncthreads();
  }
}

DI void prep_misc(const int* __restrict__ positions, const float* __restrict__ cmp_pe, const float* __restrict__ cmp_w1, float* ropec, float* ropes, float* cbias, LAS float* scr) {
  const int tid = otid();
  const double inv_tab[16] = {1.0, 0.5623413251903491, 0.31622776601683794, 0.1778279410038923, 0.1, 0.05623413251903491, 0.03162277660168379, 0.01778279410038923,
                              0.01, 0.005623413251903491, 0.0031622776601683794, 0.0017782794100389228, 0.001, 0.0005623413251903491, 0.00031622776601683794, 0.00017782794100389227};
  for (int idx = blockIdx.x * 512 + tid; idx < T * 16; idx += gridDim.x * 512) {
    const int t = idx >> 4, i = idx & 15;
    double invd = 1.0;
#pragma unroll
    for (int j = 0; j < 16; ++j) if (i == j) invd = inv_tab[j];
    const float ang = (float)positions[t] * (float)invd;
    const double a = (double)ang;
    const double rev = a * 0.15915494309189535;
    const double fr = rev - __builtin_rint(rev);
    const float rr = (float)(fr * 6.283185307179586);
    ropec[idx] = __cosf(rr); ropes[idx] = __sinf(rr);
  }
  for (int item = blockIdx.x; item < 64; item += gridDim.x) {
    const int mk = item >> 4, chunk = item & 15, col = tid & 127, kq = tid >> 7;
    const float* pe = cmp_pe + (size_t)mk * 2048 + chunk * 128 + kq * 32; const float* w1 = cmp_w1 + ((size_t)mk * 2048 + chunk * 128 + kq * 32) * 128 + col;
    float s = 0.f;
#pragma unroll
    for (int k = 0; k < 32; ++k) s += pe[k] * w1[(size_t)k * 128];
    scr[tid] = s; __syncthreads();
    if (tid < 128) cbias[item * 128 + tid] = (scr[tid] + scr[tid + 128]) + (scr[tid + 256] + scr[tid + 384]);
    __syncthreads();
  }
}

template <int MODE> DI void norm_phase(const float* __restrict__ x, const float* __restrict__ g, const float* __restrict__ sh, const float* __restrict__ sc, bf16_t* outb, float* outf) {
  const int lane = otid() & 63, wv = otid() >> 6;
#pragma unroll 2
  for (int row = blockIdx.x * 8 + wv; row < T; row += gridDim.x * 8) {
    const int b = row >> 11;
    const float4* xr = (const float4*)(x + (size_t)row * D);
    float4 v[4]; float ss = 0.f;
#pragma unroll
    for (int i = 0; i < 4; ++i) { v[i] = xr[lane + 64 * i]; ss += v[i].x * v[i].x + v[i].y * v[i].y + v[i].z * v[i].z + v[i].w * v[i].w; }
    ss = wave_sum(ss);
    const float rstd = rsqrtf(ss * (1.f / D) + EPS);
#pragma unroll
    for (int i = 0; i < 4; ++i) {
      const int col = 4 * (lane + 64 * i);
      const float4 gg = *(const float4*)(g + col);
      if (MODE == 0) {
        const float4 s1 = *(const float4*)(sc + (size_t)b * NMOD + col), s0 = *(const float4*)(sh + (size_t)b * NMOD + col);
        const float h0 = v[i].x * rstd * gg.x * (1.f + s1.x) + s0.x, h1 = v[i].y * rstd * gg.y * (1.f + s1.y) + s0.y;
        const float h2 = v[i].z * rstd * gg.z * (1.f + s1.z) + s0.z, h3 = v[i].w * rstd * gg.w * (1.f + s1.w) + s0.w;
        u32x2 w; w.x = cvt_pk_bf16(h0, h1); w.y = cvt_pk_bf16(h2, h3);
        *(u32x2*)(outb + (size_t)row * D + col) = w;
      } else {
        float4 o; o.x = v[i].x * rstd * gg.x; o.y = v[i].y * rstd * gg.y; o.z = v[i].z * rstd * gg.z; o.w = v[i].w * rstd * gg.w;
        *(float4*)(outf + (size_t)row * D + col) = o;
      }
    }
  }
}
using pg8::Unit;
typedef f32x4 AccT[2][2][4][2];

struct EpiSwiglu {
  static constexpr bool PERM = true, AFTER_DRAIN = false;
  bf16_t* U;
  DI void operator()(const AccT& acc, const Unit& u, int wr, int wc, int fr, int fq) const {
    const int row0 = u.pm * 256 + wr * 64 + fr, col0 = u.pn * 128 + wc * 32 + 8 * fq;
#pragma unroll
    for (int ai = 0; ai < 2; ++ai)
#pragma unroll
      for (int m = 0; m < 4; ++m) {
        const f32x4 a0 = acc[ai][0][m][0], a1 = acc[ai][0][m][1], b0 = acc[ai][1][m][0], b1 = acc[ai][1][m][1];
        float h[8];
#pragma unroll
        for (int e = 0; e < 4; ++e) { h[e] = siluf_(a0[e]) * b0[e]; h[4 + e] = siluf_(a1[e]) * b1[e]; }
        u32x4 w; w.x = cvt_pk_bf16(h[0], h[1]); w.y = cvt_pk_bf16(h[2], h[3]); w.z = cvt_pk_bf16(h[4], h[5]); w.w = cvt_pk_bf16(h[6], h[7]);
        __builtin_nontemporal_store(w, (u32x4*)(U + (size_t)(row0 + ai * 128 + m * 16) * DFF + col0));
        asm volatile("" ::: "memory");
      }
  }
};

struct EpiResid {
  static constexpr bool PERM = true, AFTER_DRAIN = false;
  const float* xin; float* xout; const float* gate; float coef;
  DI void operator()(const AccT& acc, const Unit& u, int wr, int wc, int fr, int fq) const {
    const int row0 = u.pm * 256 + wr * 64 + fr, col0 = u.pn * 256 + wc * 32 + 8 * fq;
    const int b = (u.pm * 256) >> 11;
    f32x4 gv[2][2];
#pragma unroll
    for (int bj = 0; bj < 2; ++bj)
#pragma unroll
      for (int n = 0; n < 2; ++n) gv[bj][n] = *(const f32x4*)(gate + (size_t)b * NMOD + col0 + bj * 128 + 4 * n) * coef;
#pragma unroll
    for (int ai = 0; ai < 2; ++ai)
#pragma unroll
      for (int m = 0; m < 4; ++m) {
        const size_t ro = (size_t)(row0 + ai * 128 + m * 16) * D;
#pragma unroll
        for (int bj = 0; bj < 2; ++bj)
#pragma unroll
          for (int n = 0; n < 2; ++n) {
            const int c = col0 + bj * 128 + 4 * n;
            const f32x4 xv = *(const f32x4*)(xin + ro + c);
            *(f32x4*)(xout + ro + c) = xv + gv[bj][n] * acc[ai][bj][m][n];
          }
        asm volatile("" ::: "memory");
      }
  }
};

struct EpiPlain {
  static constexpr bool PERM = true, AFTER_DRAIN = false;
  bf16_t* O; int ldc;
  DI void operator()(const AccT& acc, const Unit& u, int wr, int wc, int fr, int fq) const {
    const int row0 = u.pm * 256 + wr * 64 + fr, col0 = u.pn * 256 + wc * 32 + 8 * fq;
#pragma unroll
    for (int ai = 0; ai < 2; ++ai)
#pragma unroll
      for (int m = 0; m < 4; ++m)
#pragma unroll
        for (int bj = 0; bj < 2; ++bj) {
          const f32x4 v0 = acc[ai][bj][m][0], v1 = acc[ai][bj][m][1];
          u32x4 w; w.x = cvt_pk_bf16(v0[0], v0[1]); w.y = cvt_pk_bf16(v0[2], v0[3]); w.z = cvt_pk_bf16(v1[0], v1[1]); w.w = cvt_pk_bf16(v1[2], v1[3]);
          *(u32x4*)(O + (size_t)(row0 + ai * 128 + m * 16) * ldc + col0 + bj * 128) = w;
          asm volatile("" ::: "memory");
        }
  }
};

struct EpiQRope {
  static constexpr bool PERM = true, AFTER_DRAIN = false;
  bf16_t* Q; const float* rc; const float* rs; float qscale;
  DI void operator()(const AccT& acc, const Unit& u, int wr, int wc, int fr, int fq) const {
    const int row0 = u.pm * 256 + wr * 64 + fr;
#pragma unroll
    for (int bj = 0; bj < 2; ++bj) {
      const int c32 = u.pn * 256 + bj * 128 + wc * 32;
      const bool rope = (c32 % 96) == 64;
      const int col0 = c32 + 8 * fq;
#pragma unroll
      for (int ai = 0; ai < 2; ++ai)
#pragma unroll
        for (int m = 0; m < 4; ++m) {
          const int row = row0 + ai * 128 + m * 16;
          f32x4 v0 = acc[ai][bj][m][0], v1 = acc[ai][bj][m][1];
          if (rope) {
            const f32x4 cs = *(const f32x4*)(rc + (size_t)row * 16 + 4 * fq), sn = *(const f32x4*)(rs + (size_t)row * 16 + 4 * fq);
            f32x4 r0, r1;
            r0[0] = v0[0] * cs[0] - v0[1] * sn[0]; r0[1] = v0[0] * sn[0] + v0[1] * cs[0];
            r0[2] = v0[2] * cs[1] - v0[3] * sn[1]; r0[3] = v0[2] * sn[1] + v0[3] * cs[1];
            r1[0] = v1[0] * cs[2] - v1[1] * sn[2]; r1[1] = v1[0] * sn[2] + v1[1] * cs[2];
            r1[2] = v1[2] * cs[3] - v1[3] * sn[3]; r1[3] = v1[2] * sn[3] + v1[3] * cs[3];
            v0 = r0; v1 = r1;
          }
          v0 = v0 * qscale; v1 = v1 * qscale;
          u32x4 w; w.x = cvt_pk_bf16(v0[0], v0[1]); w.y = cvt_pk_bf16(v0[2], v0[3]); w.z = cvt_pk_bf16(v1[0], v1[1]); w.w = cvt_pk_bf16(v1[2], v1[3]);
          *(u32x4*)(Q + (size_t)row * 768 + col0) = w;
          asm volatile("" ::: "memory");
        }
    }
  }
};

DI void store_vt8(bf16_t* vt_base  , const f32x4& v0, const f32x4& v1) {
  const unsigned w0 = cvt_pk_bf16(v0[0], v0[1]), w1 = cvt_pk_bf16(v0[2], v0[3]), w2 = cvt_pk_bf16(v1[0], v1[1]), w3 = cvt_pk_bf16(v1[2], v1[3]);
  vt_base[0 * SEQ] = (bf16_t)(w0 & 0xffffu); vt_base[1 * SEQ] = (bf16_t)(w0 >> 16);
  vt_base[2 * SEQ] = (bf16_t)(w1 & 0xffffu); vt_base[3 * SEQ] = (bf16_t)(w1 >> 16);
  vt_base[4 * SEQ] = (bf16_t)(w2 & 0xffffu); vt_base[5 * SEQ] = (bf16_t)(w2 >> 16);
  vt_base[6 * SEQ] = (bf16_t)(w3 & 0xffffu); vt_base[7 * SEQ] = (bf16_t)(w3 >> 16);
}

struct EpiMlaKV {
  static constexpr bool PERM = true, AFTER_DRAIN = false;
  bf16_t* Kb; bf16_t* Vt;
  DI void operator()(const AccT& acc, const Unit& u, int wr, int wc, int fr, int fq) const {
    const int row0 = u.pm * 256 + wr * 64 + fr;
    const int b = (u.pm * 256) >> 11;
#pragma unroll
    for (int bj = 0; bj < 2; ++bj) {
      const int h = u.pn * 2 + bj, j0 = wc * 32 + 8 * fq;
#pragma unroll
      for (int ai = 0; ai < 2; ++ai)
#pragma unroll
        for (int m = 0; m < 4; ++m) {
          const int row = row0 + ai * 128 + m * 16, s = row & (SEQ - 1);
          const f32x4 v0 = acc[ai][bj][m][0], v1 = acc[ai][bj][m][1];
          if (wc < 2) {
            u32x4 w; w.x = cvt_pk_bf16(v0[0], v0[1]); w.y = cvt_pk_bf16(v0[2], v0[3]); w.z = cvt_pk_bf16(v1[0], v1[1]); w.w = cvt_pk_bf16(v1[2], v1[3]);
            *(u32x4*)(Kb + (size_t)row * 768 + h * 96 + j0) = w;
          } else {
            store_vt8(Vt + ((size_t)(b * 8 + h) * 64 + (j0 - 64)) * SEQ + s, v0, v1);
          }
          asm volatile("" ::: "memory");
        }
    }
  }
};

struct EpiNsaIn {
  static constexpr bool PERM = true, AFTER_DRAIN = false;
  bf16_t* Q; bf16_t* KVC; bf16_t* KS; bf16_t* VTS; bf16_t* KW; bf16_t* VTW; float* GT; const float* gate_b; float qscale;
  DI void operator()(const AccT& acc, const Unit& u, int wr, int wc, int fr, int fq) const {
    const int row0 = u.pm * 256 + wr * 64 + fr;
    const int b = (u.pm * 256) >> 11;
    const int pn = u.pn;
#pragma unroll
    for (int bj = 0; bj < 2; ++bj) {
      const int cl = bj * 128 + wc * 32 + 8 * fq;
      const int g = wc >> 1, d0 = (wc & 1) * 32 + 8 * fq;
#pragma unroll
      for (int ai = 0; ai < 2; ++ai)
#pragma unroll
        for (int m = 0; m < 4; ++m) {
          const int row = row0 + ai * 128 + m * 16, s = row & (SEQ - 1);
          f32x4 v0 = acc[ai][bj][m][0], v1 = acc[ai][bj][m][1];
          if (pn < 4) {
            v0 = v0 * qscale; v1 = v1 * qscale;
            u32x4 w; w.x = cvt_pk_bf16(v0[0], v0[1]); w.y = cvt_pk_bf16(v0[2], v0[3]); w.z = cvt_pk_bf16(v1[0], v1[1]); w.w = cvt_pk_bf16(v1[2], v1[3]);
            *(u32x4*)(Q + (size_t)row * 1024 + pn * 256 + cl) = w;
          } else if (pn == 4) {
            u32x4 w; w.x = cvt_pk_bf16(v0[0], v0[1]); w.y = cvt_pk_bf16(v0[2], v0[3]); w.z = cvt_pk_bf16(v1[0], v1[1]); w.w = cvt_pk_bf16(v1[2], v1[3]);
            *(u32x4*)(KVC + ((size_t)((bj * 8 + b) * 2 + g) * SEQ + s) * 64 + d0) = w;
          } else if (pn < 7) {
            bf16_t* Kd = pn == 5 ? KS : KW; bf16_t* Vd = pn == 5 ? VTS : VTW;
            if (bj == 0) {
              u32x4 w; w.x = cvt_pk_bf16(v0[0], v0[1]); w.y = cvt_pk_bf16(v0[2], v0[3]); w.z = cvt_pk_bf16(v1[0], v1[1]); w.w = cvt_pk_bf16(v1[2], v1[3]);
              *(u32x4*)(Kd + ((size_t)(b * 2 + g) * SEQ + s) * 64 + d0) = w;
            } else {
              store_vt8(Vd + ((size_t)(b * 2 + g) * 64 + d0) * SEQ + s, v0, v1);
            }
          } else {
            if (cl < 48) {
              const f32x4 g0 = *(const f32x4*)(gate_b + cl), g1 = *(const f32x4*)(gate_b + cl + 4);
              f32x4 o0, o1;
#pragma unroll
              for (int e = 0; e < 4; ++e) { o0[e] = sigmoidf_(v0[e] + g0[e]); o1[e] = sigmoidf_(v1[e] + g1[e]); }
              *(f32x4*)(GT + (size_t)row * 48 + cl) = o0; *(f32x4*)(GT + (size_t)row * 48 + cl + 4) = o1;
            }
          }
          asm volatile("" ::: "memory");
        }
    }
  }
};

struct EpiCmp {
  static constexpr bool PERM = true, AFTER_DRAIN = false;
  float* CH;
  DI void operator()(const AccT& acc, const Unit& u, int wr, int wc, int fr, int fq) const {
    const int row0 = u.pm * 256 + wr * 64 + fr, col0 = wc * 32 + 8 * fq;
#pragma unroll
    for (int ai = 0; ai < 2; ++ai)
#pragma unroll
      for (int m = 0; m < 4; ++m) {
        float* dst = CH + (size_t)(row0 + ai * 128 + m * 16) * 128 + col0;
        *(f32x4*)dst = acc[ai][0][m][0]; *(f32x4*)(dst + 4) = acc[ai][0][m][1];
        asm volatile("" ::: "memory");
      }
  }
};
DI void mla_prep_phase(const bf16_t* __restrict__ Z, const float* __restrict__ conv_w, const float* __restrict__ qn, const float* __restrict__ kvn,
                       const float* __restrict__ rc, const float* __restrict__ rs, bf16_t* YB, bf16_t* CQ, bf16_t* CKV, bf16_t* Kb) {
  const int lane = otid() & 63, wv = otid() >> 6;
#pragma unroll 2
  for (int t = blockIdx.x * 8 + wv; t < T; t += gridDim.x * 8) {
    const int s = t & (SEQ - 1);
    const bf16_t* zr = Z + (size_t)t * 2048;
    {
      const int c0 = lane * 8;
      float accv[8];
#pragma unroll
      for (int e = 0; e < 8; ++e) accv[e] = 0.f;
#pragma unroll
      for (int j = 0; j < 3; ++j) {
        const int dt = 2 - j;
        if (s - dt >= 0) {
          const bf16_t* zz = zr - (size_t)dt * 2048;
          const u32x4 uu = *(const u32x4*)(zz + c0), gc = *(const u32x4*)(zz + 512 + c0);
          const float4 w0 = *(const float4*)(conv_w + j * 512 + c0), w1 = *(const float4*)(conv_w + j * 512 + c0 + 4);
          accv[0] += w0.x * bflo(uu.x) * bflo(gc.x); accv[1] += w0.y * bfhi(uu.x) * bfhi(gc.x);
          accv[2] += w0.z * bflo(uu.y) * bflo(gc.y); accv[3] += w0.w * bfhi(uu.y) * bfhi(gc.y);
          accv[4] += w1.x * bflo(uu.z) * bflo(gc.z); accv[5] += w1.y * bfhi(uu.z) * bfhi(gc.z);
          accv[6] += w1.z * bflo(uu.w) * bflo(gc.w); accv[7] += w1.w * bfhi(uu.w) * bfhi(gc.w);
        }
      }
      const u32x4 gb = *(const u32x4*)(zr + 1024 + c0);
      u32x4 w;
      w.x = cvt_pk_bf16(accv[0] * bflo(gb.x), accv[1] * bfhi(gb.x)); w.y = cvt_pk_bf16(accv[2] * bflo(gb.y), accv[3] * bfhi(gb.y));
      w.z = cvt_pk_bf16(accv[4] * bflo(gb.z), accv[5] * bfhi(gb.z)); w.w = cvt_pk_bf16(accv[6] * bflo(gb.w), accv[7] * bfhi(gb.w));
      *(u32x4*)(YB + (size_t)t * 1024 + c0) = w;
    }
    {
      const u32x2 q = *(const u32x2*)(zr + 1536 + lane * 4);
      const float a0 = bflo(q.x), a1 = bfhi(q.x), a2 = bflo(q.y), a3 = bfhi(q.y);
      const float ss = wave_sum(a0 * a0 + a1 * a1 + a2 * a2 + a3 * a3);
      const float rstd = rsqrtf(ss * (1.f / 256.f) + EPS);
      const float4 gg = *(const float4*)(qn + lane * 4);
      u32x2 w; w.x = cvt_pk_bf16(a0 * rstd * gg.x, a1 * rstd * gg.y); w.y = cvt_pk_bf16(a2 * rstd * gg.z, a3 * rstd * gg.w);
      *(u32x2*)(CQ + (size_t)t * 256 + lane * 4) = w;
    }
    {
      const unsigned q = *(const unsigned*)(zr + 1792 + lane * 2);
      const float a0 = bflo(q), a1 = bfhi(q);
      const float ss = wave_sum(a0 * a0 + a1 * a1);
      const float rstd = rsqrtf(ss * (1.f / 128.f) + EPS);
      const float2 gg = *(const float2*)(kvn + lane * 2);
      *(unsigned*)(CKV + (size_t)t * 128 + lane * 2) = cvt_pk_bf16(a0 * rstd * gg.x, a1 * rstd * gg.y);
    }
    if (lane < 16) {
      const float t1 = bf2f(zr[1920 + lane]), t2 = bf2f(zr[1936 + lane]);
      const float cs = rc[(size_t)t * 16 + lane], sn = rs[(size_t)t * 16 + lane];
      const unsigned w = cvt_pk_bf16(t1 * cs - t2 * sn, t1 * sn + t2 * cs);
#pragma unroll
      for (int h = 0; h < 8; ++h) *(unsigned*)(Kb + (size_t)t * 768 + h * 96 + 64 + 2 * lane) = w;
    }
  }
}

typedef float f32x2_t_ __attribute__((ext_vector_type(2)));
typedef __bf16 bf16x2_t_ __attribute__((ext_vector_type(2)));
DI unsigned cvt_pk_v(float lo, float hi) { f32x2_t_ v = {lo, hi}; bf16x2_t_ b = __builtin_convertvector(v, bf16x2_t_); return __builtin_bit_cast(unsigned, b); }
DI float max3f_(float a, float b, float c) { float r; asm("v_max3_f32 %0, %1, %2, %3" : "=v"(r) : "v"(a), "v"(b), "v"(c)); return r; }
DI float fsub_(float a, float b) { float r; asm("v_sub_f32_e32 %0, %1, %2" : "=v"(r) : "v"(a), "v"(b)); return r; }
DI float fadd_(float a, float b) { float r; asm("s_nop 0\n\tv_add_f32_e32 %0, %1, %2" : "=v"(r) : "v"(a), "v"(b)); return r; }
DI float fmul_(float a, float b) { float r; asm("s_nop 0\n\tv_mul_f32_e32 %0, %1, %2" : "=v"(r) : "v"(a), "v"(b)); return r; }
#ifndef ATT_TWO_TILES
#define ATT_TWO_TILES(dqk, qt) ((qt) == 1 || (dqk) == 96)
#endif
constexpr int VSTR = 72;
template <int KS, int KSTR, int QT, int MM, bool QLDS>
DI void attn_step(f32x4 (&o)[QT][4], float (&m)[QT], float (&l)[QT], const bf16x8 (&qf)[QT][KS], const LAS bf16_t* Ql, const LAS bf16_t* Kl, const LAS bf16_t* Vl,
                  int lane, int kbase, const int (&lo)[QT], const int (&hi)[QT]) {
  const int r = lane & 15, g = lane >> 4;
  f32x4 s[QT][4];
#pragma unroll
  for (int kt = 0; kt < 4; ++kt) {
#pragma unroll
    for (int qt = 0; qt < QT; ++qt) s[qt][kt] = (f32x4){0.f, 0.f, 0.f, 0.f};
#pragma unroll
    for (int ks = 0; ks < KS; ++ks) {
      const bf16x8 kf = *(const LAS bf16x8*)(Kl + (kt * 16 + r) * KSTR + ks * 32 + g * 8);
#pragma unroll
      for (int qt = 0; qt < QT; ++qt) {
        const bf16x8 qv = QLDS ? *(const LAS bf16x8*)(Ql + ((qt * KS + ks) * 64 + lane) * 8) : qf[qt][ks];
        s[qt][kt] = MFMA16(kf, qv, s[qt][kt]);
      }
    }
  }
#pragma unroll
  for (int qt = 0; qt < QT; ++qt) {
    if (qt == 0) asm volatile("s_nop 7\n\ts_nop 7" : "+v"(s[qt][0]), "+v"(s[qt][1]), "+v"(s[qt][2]), "+v"(s[qt][3]));
    else asm volatile("" : "+v"(s[qt][0]), "+v"(s[qt][1]), "+v"(s[qt][2]), "+v"(s[qt][3]));
  }
#pragma unroll
  for (int qt = 0; qt < QT; ++qt) {
    float mx = -1e30f;
    if (MM == 1) {
#pragma unroll
      for (int kt = 0; kt < 4; ++kt)
#pragma unroll
        for (int i = 0; i < 4; ++i) {
          const int key = kbase + kt * 16 + g * 4 + i;
          const bool valid = (key >= lo[qt]) && (key <= hi[qt]);
          const float sv = valid ? s[qt][kt][i] : -1e30f;
          s[qt][kt][i] = sv; mx = fmaxf(mx, sv);
        }
    } else {
#pragma unroll
      for (int kt = 0; kt < 4; ++kt) { mx = max3f_(mx, s[qt][kt][0], s[qt][kt][1]); mx = max3f_(mx, s[qt][kt][2], s[qt][kt][3]); }
      if (MM == 2) mx = (lo[qt] == 0) ? mx : -1e30f;
    }
    mx = max3f_(mx, __shfl_xor(mx, 16), -1e30f); mx = max3f_(mx, __shfl_xor(mx, 32), -1e30f);
    const float mn = max3f_(m[qt], mx, -1e30f);
    const float alpha = fast_exp2(m[qt] - mn);
    float rsum = 0.f;
    if (MM == 1) {
#pragma unroll
      for (int kt = 0; kt < 4; ++kt)
#pragma unroll
        for (int i = 0; i < 4; ++i) {
          const float sv = s[qt][kt][i];
          const float pv = (sv > -1e29f) ? fast_exp2(sv - mn) : 0.f;
          s[qt][kt][i] = pv; rsum += pv;
        }
    } else {
      const float mne = (MM == 2) ? ((lo[qt] == 0) ? mn : 1e30f) : mn;
      f32x4 ps = (f32x4){0.f, 0.f, 0.f, 0.f};
#pragma unroll
      for (int kt = 0; kt < 4; ++kt) {
        const f32x4 dv = s[qt][kt] - mne;
        f32x4 pv; pv[0] = fast_exp2(dv[0]); pv[1] = fast_exp2(dv[1]); pv[2] = fast_exp2(dv[2]); pv[3] = fast_exp2(dv[3]);
        s[qt][kt] = pv; ps = ps + pv;
      }
      rsum = (ps[0] + ps[1]) + (ps[2] + ps[3]);
    }
    rsum += __shfl_xor(rsum, 16); rsum += __shfl_xor(rsum, 32);
    l[qt] = l[qt] * alpha + rsum; m[qt] = mn;
    if (!__all(alpha == 1.0f)) {
#pragma unroll
      for (int dt = 0; dt < 4; ++dt) o[qt][dt] = o[qt][dt] * alpha;
    }
  }
#pragma unroll
  for (int k2 = 0; k2 < 2; ++k2) {
    bf16x8 pb[QT];
#pragma unroll
    for (int qt = 0; qt < QT; ++qt) {
      u32x4 w; w.x = cvt_pk_v(s[qt][2 * k2][0], s[qt][2 * k2][1]); w.y = cvt_pk_v(s[qt][2 * k2][2], s[qt][2 * k2][3]);
      w.z = cvt_pk_v(s[qt][2 * k2 + 1][0], s[qt][2 * k2 + 1][1]); w.w = cvt_pk_v(s[qt][2 * k2 + 1][2], s[qt][2 * k2 + 1][3]);
      pb[qt] = __builtin_bit_cast(bf16x8, w);
    }
#pragma unroll
    for (int dt = 0; dt < 4; ++dt) {
      const LAS bf16_t* vp = Vl + (dt * 16 + r) * VSTR + k2 * 32 + 4 * g;
      const u32x2 lo2 = *(const LAS u32x2*)vp, hi2 = *(const LAS u32x2*)(vp + 16);
      u32x4 vv; vv.x = lo2.x; vv.y = lo2.y; vv.z = hi2.x; vv.w = hi2.y;
      const bf16x8 vf = __builtin_bit_cast(bf16x8, vv);
#pragma unroll
      for (int qt = 0; qt < QT; ++qt) o[qt][dt] = MFMA16(vf, pb[qt], o[qt][dt]);
    }
  }
}

template <int DQK, int QT, int MODE, bool QLDS>
DI void attn_tile(f32x4 (&o)[QT][4], float (&m)[QT], float (&l)[QT], const bf16x8 (&qf)[QT][DQK / 32], const LAS bf16_t* Ql, const LAS bf16_t* Kl, const LAS bf16_t* Vl,
                  int j, const int (&tq)[QT], const unsigned (&sel)[QT], int twave_min, int twave_max) {
  constexpr int KSTR = DQK + 8, KS = DQK / 32;
  const int lane = otid() & 63;
  const int kbase = j * 64;
  if (MODE == 1) { bool anysel = false;
#pragma unroll
    for (int qt = 0; qt < QT; ++qt) anysel = anysel || ((sel[qt] >> j) & 1u);
    if (!__any(anysel)) return; }
  bool act;
  if (MODE == 2) act = (kbase + 63 >= twave_min - 511) && (kbase <= twave_max); else act = (kbase <= twave_max);
  if (act) {
    int lo[QT], hi[QT];
    bool full = true;
#pragma unroll
    for (int qt = 0; qt < QT; ++qt) {
      hi[qt] = tq[qt];
      if (MODE == 0) lo[qt] = 0; else if (MODE == 1) lo[qt] = ((sel[qt] >> j) & 1u) ? 0 : 0x7fffffff; else lo[qt] = tq[qt] - 511;
      full = full && (lo[qt] <= kbase) && (hi[qt] >= kbase + 63);
    }
    if (__all(full)) attn_step<KS, KSTR, QT, 0, QLDS>(o, m, l, qf, Ql, Kl, Vl, lane, kbase, lo, hi);
    else if (MODE == 1 && kbase + 63 <= twave_min) attn_step<KS, KSTR, QT, 2, QLDS>(o, m, l, qf, Ql, Kl, Vl, lane, kbase, lo, hi);
    else attn_step<KS, KSTR, QT, 1, QLDS>(o, m, l, qf, Ql, Kl, Vl, lane, kbase, lo, hi);
  }
}

template <int DQK, int QT, int MODE, bool QLDS>
DI void attn_loop(f32x4 (&o)[QT][4], float (&m)[QT], float (&l)[QT], const bf16x8 (&qf)[QT][DQK / 32], const LAS bf16_t* Ql, unsigned rem,
                  const bf16_t* __restrict__ Kg, int kstride, const bf16_t* __restrict__ Vtg, int vstride,
                  LAS bf16_t* Kl0, LAS bf16_t* Vl0, const int (&tq)[QT], const unsigned (&sel)[QT], int twave_min, int twave_max) {
  constexpr int KSTR = DQK + 8, CPR = DQK / 8, NKC = (64 * CPR + 511) / 512;
  constexpr int KBUF = 64 * KSTR, VBUF = 64 * VSTR;
  const int tid = otid();
  constexpr bool TWO = ATT_TWO_TILES(DQK, QT); constexpr int SL = TWO ? 2 : 1;
  u32x4 krA[NKC], vrA, krB[TWO ? NKC : 1], vrB;
#define ATT_GLOAD(jj, KR, VR) do { _Pragma("unroll") for (int c_ = 0; c_ < NKC; ++c_) { const int ch_ = tid + c_ * 512; if (ch_ < 64 * CPR) { const int row_ = ch_ / CPR, cc_ = ch_ - row_ * CPR; \
      KR[c_] = *(const u32x4*)(Kg + (size_t)((jj) * 64 + row_) * kstride + cc_ * 8); } } \
    { const int d_ = tid >> 3, cc_ = tid & 7; VR = *(const u32x4*)(Vtg + (size_t)d_ * vstride + (jj) * 64 + cc_ * 8); } } while (0)
#define ATT_LSTORE(slot, KR, VR) do { _Pragma("unroll") for (int c_ = 0; c_ < NKC; ++c_) { const int ch_ = tid + c_ * 512; if (ch_ < 64 * CPR) { const int row_ = ch_ / CPR, cc_ = ch_ - row_ * CPR; \
      *(LAS u32x4*)(Kl0 + (slot) * KBUF + row_ * KSTR + cc_ * 8) = KR[c_]; } } \
    { const int d_ = tid >> 3, cc_ = tid & 7; *(LAS u32x4*)(Vl0 + (slot) * VBUF + d_ * VSTR + cc_ * 8) = VR; } } while (0)
  if (rem == 0u) return;
  int j0 = __builtin_ctz(rem); rem &= rem - 1u;
  int j1 = -1; if (TWO && rem) { j1 = __builtin_ctz(rem); rem &= rem - 1u; }
  ATT_GLOAD(j0, krA, vrA); if (TWO && j1 >= 0) ATT_GLOAD(j1, krB, vrB);
  ATT_LSTORE(0, krA, vrA); if (TWO && j1 >= 0) ATT_LSTORE(1, krB, vrB);
  __syncthreads();
  int buf = 0;
  for (;;) {
    int n0 = -1, n1 = -1;
    if (rem) { n0 = __builtin_ctz(rem); rem &= rem - 1u; ATT_GLOAD(n0, krA, vrA); }
    if (TWO && rem) { n1 = __builtin_ctz(rem); rem &= rem - 1u; ATT_GLOAD(n1, krB, vrB); }
    attn_tile<DQK, QT, MODE, QLDS>(o, m, l, qf, Ql, Kl0 + (buf * SL) * KBUF, Vl0 + (buf * SL) * VBUF, j0, tq, sel, twave_min, twave_max);
    if (TWO && j1 >= 0) attn_tile<DQK, QT, MODE, QLDS>(o, m, l, qf, Ql, Kl0 + (buf * SL + 1) * KBUF, Vl0 + (buf * SL + 1) * VBUF, j1, tq, sel, twave_min, twave_max);
    if (n0 >= 0) ATT_LSTORE((buf ^ 1) * SL, krA, vrA);
    if (TWO && n1 >= 0) ATT_LSTORE((buf ^ 1) * SL + 1, krB, vrB);
    __syncthreads();
    if (n0 < 0) break;
    j0 = n0; j1 = n1; buf ^= 1;
  }
#undef ATT_GLOAD
#undef ATT_LSTORE
}


template <int MODE>
DI void attn_loop_pair(f32x4 (&oA)[1][4], float (&mA)[1], float (&lA)[1], const bf16x8 (&qA)[1][2], const int (&tqA)[1], const unsigned (&selA)[1], int tminA, int tmaxA,
                       f32x4 (&oB)[1][4], float (&mB)[1], float (&lB)[1], const bf16x8 (&qB)[1][2], const int (&tqB)[1], const unsigned (&selB)[1], int tminB, int tmaxB,
                       unsigned rem, const bf16_t* __restrict__ Kg, int kstride, const bf16_t* __restrict__ Vtg, int vstride, LAS bf16_t* Kl0, LAS bf16_t* Vl0) {
  constexpr int KSTR = 72, KBUF = 64 * KSTR, VBUF = 64 * VSTR;
  const int tid = otid();
  const int krow = tid >> 3, kcc = tid & 7;
  u32x4 kA, vA, kB, vB;
#define PR_GLOAD(jj, KR, VR) do { KR = *(const u32x4*)(Kg + (size_t)((jj) * 64 + krow) * kstride + kcc * 8); VR = *(const u32x4*)(Vtg + (size_t)krow * vstride + (jj) * 64 + kcc * 8); } while (0)
#define PR_LSTORE(slot, KR, VR) do { *(LAS u32x4*)(Kl0 + (slot) * KBUF + krow * KSTR + kcc * 8) = KR; *(LAS u32x4*)(Vl0 + (slot) * VBUF + krow * VSTR + kcc * 8) = VR; } while (0)
#define PR_TILE(slot, jj) do { \
    attn_tile<64, 1, MODE, false>(oA, mA, lA, qA, (const LAS bf16_t*)nullptr, Kl0 + (slot) * KBUF, Vl0 + (slot) * VBUF, (jj), tqA, selA, tminA, tmaxA); \
    attn_tile<64, 1, MODE, false>(oB, mB, lB, qB, (const LAS bf16_t*)nullptr, Kl0 + (slot) * KBUF, Vl0 + (slot) * VBUF, (jj), tqB, selB, tminB, tmaxB); } while (0)
  if (rem == 0u) return;
  int j0 = __builtin_ctz(rem); rem &= rem - 1u;
  int j1 = -1; if (rem) { j1 = __builtin_ctz(rem); rem &= rem - 1u; }
  PR_GLOAD(j0, kA, vA); if (j1 >= 0) PR_GLOAD(j1, kB, vB);
  PR_LSTORE(0, kA, vA); if (j1 >= 0) PR_LSTORE(1, kB, vB);
  __syncthreads();
  int buf = 0;
  for (;;) {
    int n0 = -1, n1 = -1;
    if (rem) { n0 = __builtin_ctz(rem); rem &= rem - 1u; PR_GLOAD(n0, kA, vA); }
    if (rem) { n1 = __builtin_ctz(rem); rem &= rem - 1u; PR_GLOAD(n1, kB, vB); }
    PR_TILE(buf * 2, j0);
    if (j1 >= 0) PR_TILE(buf * 2 + 1, j1);
    if (n0 >= 0) PR_LSTORE((buf ^ 1) * 2, kA, vA);
    if (n1 >= 0) PR_LSTORE((buf ^ 1) * 2 + 1, kB, vB);
    __syncthreads();
    if (n0 < 0) break;
    j0 = n0; j1 = n1; buf ^= 1;
  }
#undef PR_GLOAD
#undef PR_LSTORE
#undef PR_TILE
}

DI void mla_attn_phase(const bf16_t* __restrict__ Qb, const bf16_t* __restrict__ Kb, const bf16_t* __restrict__ Vt, bf16_t* YB, LAS unsigned char* lds) {
  constexpr int QT = 2, DQK = 96, KS = 3;
  LAS bf16_t* Kl = (LAS bf16_t*)lds; LAS bf16_t* Vl = (LAS bf16_t*)(lds + 4 * 64 * (DQK + 8) * 2);
  const int tid = otid(), lane = tid & 63, wv = __builtin_amdgcn_readfirstlane(tid >> 6), G = gridDim.x, c = blockIdx.x;
  const bool xl = (G & 7) == 0;
  const int nsl = xl ? (G >> 3) : G, xcd = c & 7, slot = xl ? (c >> 3) : c, nun = xl ? 64 : 512;
  for (int rnd = 0; rnd * nsl < nun; ++rnd) {
    const int v = (rnd & 1) ? (rnd + 1) * nsl - 1 - slot : rnd * nsl + slot;
    if (v >= nun) continue;
    const int qb = 7 - (xl ? (v >> 3) : (v >> 6)), bh = xl ? (xcd * 8 + (v & 7)) : (v & 63), b = bh >> 3, h = bh & 7;
    const int q0 = qb * 256 + wv * 32;
    bf16x8 qf[QT][KS];
#pragma unroll
    for (int qt = 0; qt < QT; ++qt)
#pragma unroll
      for (int ks = 0; ks < KS; ++ks)
        qf[qt][ks] = *(const bf16x8*)(Qb + (size_t)(b * SEQ + q0 + qt * 16 + (lane & 15)) * 768 + h * 96 + ks * 32 + (lane >> 4) * 8);
    f32x4 o[QT][4]; float m[QT], l[QT]; int tq[QT]; unsigned sel[QT];
#pragma unroll
    for (int qt = 0; qt < QT; ++qt) { m[qt] = -1e30f; l[qt] = 0.f; tq[qt] = q0 + qt * 16 + (lane & 15); sel[qt] = 0u;
#pragma unroll
      for (int dt = 0; dt < 4; ++dt) o[qt][dt] = (f32x4){0.f, 0.f, 0.f, 0.f}; }
    const int jhi = (qb * 256 + 255) >> 6;
    const unsigned rem = (2u << jhi) - 1u;
    attn_loop<DQK, QT, 0, false>(o, m, l, qf, (const LAS bf16_t*)nullptr, rem, Kb + (size_t)b * SEQ * 768 + h * 96, 768, Vt + (size_t)(b * 8 + h) * 64 * SEQ, SEQ, Kl, Vl, tq, sel, q0, q0 + 31);
#pragma unroll
    for (int qt = 0; qt < QT; ++qt) {
      const float inv = 1.f / fmaxf(l[qt], 1e-20f);
      bf16_t* dst = YB + (size_t)(b * SEQ + tq[qt]) * 1024 + 512 + h * 64 + (lane >> 4) * 4;
#pragma unroll
      for (int dt = 0; dt < 4; ++dt) { const f32x4 v = o[qt][dt] * inv; u32x2 w; w.x = cvt_pk_bf16(v[0], v[1]); w.y = cvt_pk_bf16(v[2], v[3]); *(u32x2*)(dst + dt * 16) = w; }
    }
  }
}
DI void nsa_cmp2_phase(const float* __restrict__ CH  , const float* __restrict__ cbias  , const float* __restrict__ w2  , bf16_t* KC, bf16_t* VTC, LAS float* wl) {
  const int lane = otid() & 63, wv = otid() >> 6;
  for (int i = otid(); i < 2 * 128 * 64; i += 512) wl[i] = w2[i];
  __syncthreads();
  for (int item = blockIdx.x * 8 + wv; item < 2 * 2048; item += gridDim.x * 8) {
    const int kind = item >> 11, row = item & 2047, bg = row >> 7, n = row & 127;
    const float* ch = CH + ((size_t)kind * 8 * 2048 + row) * 128;
    const LAS float* w = wl + kind * 128 * 64 + lane;
    float c0 = 0.f, c1 = 0.f;
#pragma unroll
    for (int q = 0; q < 16; ++q) { c0 += cbias[(kind * 16 + q) * 128 + lane]; c1 += cbias[(kind * 16 + q) * 128 + 64 + lane]; }
#pragma unroll
    for (int cc = 0; cc < 8; ++cc) { c0 += ch[(size_t)cc * 2048 * 128 + lane]; c1 += ch[(size_t)cc * 2048 * 128 + 64 + lane]; }
    c0 = siluf_(c0); c1 = siluf_(c1);
    float acc = 0.f;
#pragma unroll 8
    for (int h = 0; h < 64; ++h) acc += __shfl(c0, h) * w[h * 64];
#pragma unroll 8
    for (int h = 0; h < 64; ++h) acc += __shfl(c1, h) * w[(64 + h) * 64];
    if (n == 127) acc = 0.f;
    const bf16_t o = (bf16_t)(cvt_pk_bf16(acc, 0.f) & 0xffffu);
    if (kind == 0) KC[((size_t)bg * 128 + n) * 64 + lane] = o; else VTC[((size_t)bg * 64 + lane) * 128 + n] = o;
  }
}

#ifndef NSA_QT
#define NSA_QT 2
#endif
constexpr int NSA_TQ = 16 * NSA_QT;
constexpr bool NSA_QL = (NSA_QT == 2);
constexpr int NSA_SLOTS = ATT_TWO_TILES(64, NSA_QT) ? 4 : 2;
constexpr int N_IMP = 8 * NSA_TQ * 32 * 4, N_IMPF = NSA_TQ * 33 * 4;
constexpr int N_KL = NSA_SLOTS * 64 * 72 * 2, N_VL0 = NSA_SLOTS * 64 * VSTR * 2, N_VL = (N_KL + N_VL0 >= N_IMP + N_IMPF ? N_VL0 : ((N_IMP + N_IMPF - N_KL + 255) & ~255)), N_KC = 128 * 72 * 2, N_VC = 64 * 136 * 2, N_QL = NSA_QL ? 8 * NSA_QT * 2 * 64 * 16 : 0;
constexpr int O_KL = 0, O_VL = O_KL + N_KL, O_KC = O_VL + N_VL, O_VC = O_KC + N_KC, O_SEL = O_VC + N_VC, O_QL = O_SEL + 256, O_END = O_QL + N_QL;
constexpr int O_IMP = O_KL, O_IMPF = O_IMP + N_IMP;
static_assert(N_IMP + N_IMPF <= N_KL + N_VL, "NSA LDS alias");
static_assert(O_END <= LDS_BYTES - 256, "NSA LDS map");
DI void nsa_attn_phase(unsigned char* ws, LAS unsigned char* lds) {
#define Qb  ((const bf16_t*)(ws + WS_QB))
#define KC  ((const bf16_t*)(ws + WS_KC))
#define VTC ((const bf16_t*)(ws + WS_VTC))
#define KS  ((const bf16_t*)(ws + WS_KS))
#define VTS ((const bf16_t*)(ws + WS_VTS))
#define KW  ((const bf16_t*)(ws + WS_KW))
#define VTW ((const bf16_t*)(ws + WS_VTW))
#define GT  ((const float*)(ws + WS_GT))
#define YB  ((bf16_t*)(ws + WS_YB))
#define YF  ((float*)(ws + WS_YF))
  constexpr int QT = NSA_QT, TQ = NSA_TQ, NTB = SEQ / TQ;
  LAS bf16_t* Kl = (LAS bf16_t*)(lds + O_KL); LAS bf16_t* Vl = (LAS bf16_t*)(lds + O_VL);
  LAS bf16_t* Kc = (LAS bf16_t*)(lds + O_KC); LAS bf16_t* Vc = (LAS bf16_t*)(lds + O_VC);
  LAS float* IMP = (LAS float*)(lds + O_IMP); LAS float* IMPF = (LAS float*)(lds + O_IMPF); LAS unsigned* SEL = (LAS unsigned*)(lds + O_SEL);
  const int tid = otid(), lane = tid & 63, wv = __builtin_amdgcn_readfirstlane(tid >> 6), G = gridDim.x, c = blockIdx.x;
  LAS bf16_t* Ql = (LAS bf16_t*)(lds + O_QL) + (NSA_QL ? wv * (QT * 2 * 64 * 8) : 0);
  const int r = lane & 15, g4 = lane >> 4;
  const bool xl = (G & 15) == 0;
  const int nsl = xl ? (G >> 4) : G, slot = xl ? (c >> 4) : c, nun = xl ? NTB : NTB * 16;
  int last_bg = -1;
  for (int rnd = 0; rnd * nsl < nun; ++rnd) {
    const int v = (rnd & 1) ? (rnd + 1) * nsl - 1 - slot : rnd * nsl + slot;
    if (v >= nun) continue;
    const int tb = (NTB - 1) - (xl ? v : (v >> 4)), bg = xl ? ((c & 7) + 8 * ((c >> 3) & 1)) : (v & 15), b = bg >> 1, g = bg & 1;
    const int t0 = tb * TQ, head = g * 8 + wv;
    if (bg != last_bg) {
    for (int ch = tid; ch < 128 * 8; ch += 512) { const int row = ch >> 3, cc = ch & 7; *(LAS u32x4*)(Kc + row * 72 + cc * 8) = *(const u32x4*)(KC + ((size_t)bg * 128 + row) * 64 + cc * 8); }
    for (int ch = tid; ch < 64 * 16; ch += 512) { const int row = ch >> 4, cc = ch & 15; *(LAS u32x4*)(Vc + row * 136 + cc * 8) = *(const u32x4*)(VTC + ((size_t)bg * 64 + row) * 128 + cc * 8); }
    last_bg = bg; }
    if (tid == 0) SEL[32] = 0u;
    bf16x8 qf[QT][2]; int tq[QT];
    constexpr bool OFR = (NSA_QT == 1);
    f32x4 ofin[QT][4];
#pragma unroll
    for (int qt = 0; qt < QT; ++qt) {
      tq[qt] = t0 + qt * 16 + r;
      const size_t tok = (size_t)b * SEQ + tq[qt];
#pragma unroll
      for (int ks = 0; ks < 2; ++ks) { qf[qt][ks] = *(const bf16x8*)(Qb + tok * 1024 + head * 64 + ks * 32 + g4 * 8);
        if (NSA_QL) *(LAS bf16x8*)(Ql + ((qt * 2 + ks) * 64 + lane) * 8) = qf[qt][ks]; }
    }
    __syncthreads();
#ifndef NSA_REP_C
#define NSA_REP_C 1
#define NSA_REP_S 1
#define NSA_REP_W 1
#endif
    for (int repc = 0; repc < NSA_REP_C; ++repc) {
    {
      const int tlc = otid(); const int r = tlc & 15, g4 = (tlc >> 4) & 3, lane = tlc & 63;
#pragma unroll
      for (int qt = 0; qt < QT; ++qt) {
        f32x4 oc[4];
#pragma unroll
        for (int dt = 0; dt < 4; ++dt) oc[dt] = (f32x4){0.f, 0.f, 0.f, 0.f};
        f32x4 sc[8];
#pragma unroll
        for (int kt = 0; kt < 8; ++kt) {
          sc[kt] = (f32x4){0.f, 0.f, 0.f, 0.f};
#pragma unroll
          for (int ks = 0; ks < 2; ++ks) {
            const bf16x8 kf = *(const LAS bf16x8*)(Kc + (kt * 16 + r) * 72 + ks * 32 + g4 * 8);
            const bf16x8 qv = NSA_QL ? *(const LAS bf16x8*)(Ql + ((qt * 2 + ks) * 64 + lane) * 8) : qf[qt][ks];
            sc[kt] = MFMA16(kf, qv, sc[kt]);
          }
        }
        float mx = -1e30f;
#pragma unroll
        for (int kt = 0; kt < 8; ++kt)
#pragma unroll
          for (int i = 0; i < 4; ++i) {
            const int n = kt * 16 + g4 * 4 + i;
            const bool valid = (16 * n + 31 <= tq[qt]) && (n < 127);
            const float sv = valid ? sc[kt][i] : -1e30f;
            sc[kt][i] = sv; mx = fmaxf(mx, sv);
          }
        mx = fmaxf(mx, __shfl_xor(mx, 16)); mx = fmaxf(mx, __shfl_xor(mx, 32));
        float rsum = 0.f;
#pragma unroll
        for (int kt = 0; kt < 8; ++kt)
#pragma unroll
          for (int i = 0; i < 4; ++i) { const float sv = sc[kt][i]; const float pv = (sv > -1e29f) ? fast_exp2(sv - mx) : 0.f; sc[kt][i] = pv; rsum += pv; }
        rsum += __shfl_xor(rsum, 16); rsum += __shfl_xor(rsum, 32);
        const float inv = 1.f / fmaxf(rsum, 1e-20f);
        float prevb = 0.f;
#pragma unroll
        for (int kt = 0; kt < 8; ++kt) {
          sc[kt] = sc[kt] * inv;
          const float a = (sc[kt][0] + sc[kt][1]) + (sc[kt][2] + 0.5f * sc[kt][3]);
          const float bcur = 0.5f * sc[kt][3];
          const float up = __shfl(bcur, (lane + 48) & 63);
          const float wrap = __shfl(prevb, (lane + 48) & 63);
          IMP[(wv * TQ + qt * 16 + r) * 32 + kt * 4 + g4] = a + (g4 > 0 ? up : wrap);
          prevb = bcur;
        }
#pragma unroll
        for (int k4 = 0; k4 < 4; ++k4) {
          u32x4 w; w.x = cvt_pk_v(sc[2 * k4][0], sc[2 * k4][1]); w.y = cvt_pk_v(sc[2 * k4][2], sc[2 * k4][3]);
          w.z = cvt_pk_v(sc[2 * k4 + 1][0], sc[2 * k4 + 1][1]); w.w = cvt_pk_v(sc[2 * k4 + 1][2], sc[2 * k4 + 1][3]);
          const bf16x8 pb = __builtin_bit_cast(bf16x8, w);
#pragma unroll
          for (int dt = 0; dt < 4; ++dt) {
            const LAS bf16_t* vp = Vc + (dt * 16 + r) * 136 + k4 * 32 + 4 * g4;
            const u32x2 lo2 = *(const LAS u32x2*)vp, hi2 = *(const LAS u32x2*)(vp + 16);
            u32x4 vv; vv.x = lo2.x; vv.y = lo2.y; vv.z = hi2.x; vv.w = hi2.y;
            oc[dt] = MFMA16(__builtin_bit_cast(bf16x8, vv), pb, oc[dt]);
          }
        }
        { const float g0 = GT[((size_t)b * SEQ + tq[qt]) * 48 + head * 3 + 0];
          float* yf = YF + ((size_t)b * SEQ + tq[qt]) * 1024 + head * 64 + g4 * 4;
#pragma unroll
          for (int dt = 0; dt < 4; ++dt) { if (OFR) ofin[qt][dt] = oc[dt] * g0; else *(f32x4*)(yf + dt * 16) = oc[dt] * g0; } }
        asm volatile("" ::: "memory");
      }
    }
    __syncthreads();
    for (int idx = tid; idx < TQ * 32; idx += 512) {
      const int q = idx >> 5, j = idx & 31; float sgm = 0.f;
#pragma unroll
      for (int h = 0; h < 8; ++h) sgm += IMP[(h * TQ + q) * 32 + j];
      IMPF[q * 33 + j] = sgm;
    }
    __syncthreads();
    for (int idx = tid; idx < TQ * 32; idx += 512) {
      const int q = idx >> 5, j = idx & 31, t = t0 + q, cur = t >> 6;
      const bool forced = (j == 0) || (j == cur) || (j == cur - 1), causal = (j <= cur), cand = causal && !forced;
      const float my = IMPF[q * 33 + j];
      int rank = 0;
#pragma unroll
      for (int jj = 0; jj < 32; ++jj) {
        const float v = IMPF[q * 33 + jj];
        const bool cj = (jj <= cur) && !((jj == 0) || (jj == cur) || (jj == cur - 1));
        rank += (cj && (v > my || (v == my && jj < j))) ? 1 : 0;
      }
      const bool sbit = causal && (forced || cur < 8 || (cand && rank < 5));
      const unsigned long long bal = __ballot(sbit);
      if ((lane & 31) == 0) { const unsigned sl = (lane == 0) ? (unsigned)bal : (unsigned)(bal >> 32); SEL[q] = sl; __hip_atomic_fetch_or(&SEL[32], sl, __ATOMIC_RELAXED, __HIP_MEMORY_SCOPE_WORKGROUP); }
    }
    __syncthreads();
    }
    unsigned sel[QT];
#pragma unroll
    for (int qt = 0; qt < QT; ++qt) sel[qt] = SEL[qt * 16 + r];
    const unsigned uni = (unsigned)__builtin_amdgcn_readfirstlane((int)SEL[32]);
    {
      f32x4 o[QT][4]; float m[QT], l[QT];
#pragma unroll
      for (int qt = 0; qt < QT; ++qt) { m[qt] = -1e30f; l[qt] = 0.f;
#pragma unroll
        for (int dt = 0; dt < 4; ++dt) o[qt][dt] = (f32x4){0.f, 0.f, 0.f, 0.f}; }
      for (int reps = 0; reps < NSA_REP_S; ++reps) {
#pragma unroll
      for (int qt = 0; qt < QT; ++qt) { m[qt] = -1e30f; l[qt] = 0.f;
#pragma unroll
        for (int dt = 0; dt < 4; ++dt) o[qt][dt] = (f32x4){0.f, 0.f, 0.f, 0.f}; }
      attn_loop<64, QT, 1, NSA_QL>(o, m, l, qf, Ql, uni, KS + (size_t)bg * SEQ * 64, 64, VTS + (size_t)bg * 64 * SEQ, SEQ, Kl, Vl, tq, sel, t0, t0 + TQ - 1); }
#pragma unroll
      for (int qt = 0; qt < QT; ++qt) { const float sc1 = GT[((size_t)b * SEQ + tq[qt]) * 48 + head * 3 + 1] / fmaxf(l[qt], 1e-20f);
        float* yf = YF + ((size_t)b * SEQ + tq[qt]) * 1024 + head * 64 + g4 * 4;
#pragma unroll
        for (int dt = 0; dt < 4; ++dt) { if (OFR) ofin[qt][dt] = ofin[qt][dt] + o[qt][dt] * sc1; else *(f32x4*)(yf + dt * 16) = *(const f32x4*)(yf + dt * 16) + o[qt][dt] * sc1; } }
    }
    {
      f32x4 o[QT][4]; float m[QT], l[QT];
#pragma unroll
      for (int qt = 0; qt < QT; ++qt) { m[qt] = -1e30f; l[qt] = 0.f;
#pragma unroll
        for (int dt = 0; dt < 4; ++dt) o[qt][dt] = (f32x4){0.f, 0.f, 0.f, 0.f}; }
      const int jlo = (t0 - 511 > 0 ? t0 - 511 : 0) >> 6, jhi = (t0 + TQ - 1) >> 6;
      const unsigned remw = ((2u << jhi) - 1u) & ~((1u << jlo) - 1u);
      for (int repw = 0; repw < NSA_REP_W; ++repw) {
#pragma unroll
      for (int qt = 0; qt < QT; ++qt) { m[qt] = -1e30f; l[qt] = 0.f;
#pragma unroll
        for (int dt = 0; dt < 4; ++dt) o[qt][dt] = (f32x4){0.f, 0.f, 0.f, 0.f}; }
      attn_loop<64, QT, 2, NSA_QL>(o, m, l, qf, Ql, remw, KW + (size_t)bg * SEQ * 64, 64, VTW + (size_t)bg * 64 * SEQ, SEQ, Kl, Vl, tq, sel, t0, t0 + TQ - 1); }
#pragma unroll
      for (int qt = 0; qt < QT; ++qt) { const float sc2 = GT[((size_t)b * SEQ + tq[qt]) * 48 + head * 3 + 2] / fmaxf(l[qt], 1e-20f);
        const float* yf = YF + ((size_t)b * SEQ + tq[qt]) * 1024 + head * 64 + g4 * 4;
        bf16_t* dst = YB + ((size_t)b * SEQ + tq[qt]) * 1024 + head * 64 + g4 * 4;
#pragma unroll
        for (int dt = 0; dt < 4; ++dt) { const f32x4 v = (OFR ? ofin[qt][dt] : *(const f32x4*)(yf + dt * 16)) + o[qt][dt] * sc2; u32x2 w; w.x = cvt_pk_bf16(v[0], v[1]); w.y = cvt_pk_bf16(v[2], v[3]); *(u32x2*)(dst + dt * 16) = w; } }
    }
    __syncthreads();
  }
}
#undef Qb
#undef KC
#undef VTC
#undef KS
#undef VTS
#undef KW
#undef VTW
#undef GT
#undef YB
#undef YF

constexpr int P_KL = 0, P_VL = P_KL + 4 * 64 * 72 * 2, P_KC = P_VL + 4 * 64 * VSTR * 2, P_VC = P_KC + 128 * 72 * 2, P_SEL = P_VC + 64 * 136 * 2, P_IMPF = P_SEL + 256, P_END = P_IMPF + 32 * 33 * 4;
static_assert(P_END <= LDS_BYTES - 256, "NSA pair LDS map");
DI void nsa_attn_phase2(unsigned char* ws, LAS unsigned char* lds) {
#define Qb  ((const bf16_t*)(ws + WS_QB))
#define KC  ((const bf16_t*)(ws + WS_KC))
#define VTC ((const bf16_t*)(ws + WS_VTC))
#define KS  ((const bf16_t*)(ws + WS_KS))
#define VTS ((const bf16_t*)(ws + WS_VTS))
#define KW  ((const bf16_t*)(ws + WS_KW))
#define VTW ((const bf16_t*)(ws + WS_VTW))
#define GT  ((const float*)(ws + WS_GT))
#define YB  ((bf16_t*)(ws + WS_YB))
#define YF  ((float*)(ws + WS_YF))
  constexpr int TQ = 32, NTB = SEQ / TQ;
  LAS bf16_t* Kl = (LAS bf16_t*)(lds + P_KL); LAS bf16_t* Vl = (LAS bf16_t*)(lds + P_VL);
  LAS bf16_t* Kc = (LAS bf16_t*)(lds + P_KC); LAS bf16_t* Vc = (LAS bf16_t*)(lds + P_VC);
  LAS float* IMPF = (LAS float*)(lds + P_IMPF); LAS unsigned* SEL = (LAS unsigned*)(lds + P_SEL);
  const int tid = otid(), lane = tid & 63, wv = __builtin_amdgcn_readfirstlane(tid >> 6), G = gridDim.x, c = blockIdx.x;
  const int r = lane & 15, g4 = lane >> 4, tokl = r >> 3, hl = r & 7;
  const bool xl = (G & 15) == 0;
  const int nsl = xl ? (G >> 4) : G, slot = xl ? (c >> 4) : c, nun = xl ? NTB : NTB * 16;
  int last_bg = -1;
  for (int rnd = 0; rnd * nsl < nun; ++rnd) {
    const int v = (rnd & 1) ? (rnd + 1) * nsl - 1 - slot : rnd * nsl + slot;
    if (v >= nun) continue;
    const int tb = (NTB - 1) - (xl ? v : (v >> 4)), bg = xl ? ((c & 7) + 8 * ((c >> 3) & 1)) : (v & 15), b = bg >> 1, g = bg & 1;
    const int t0 = tb * TQ, head = g * 8 + hl;
    if (bg != last_bg) {
      for (int ch = tid; ch < 128 * 8; ch += 512) { const int row = ch >> 3, cc = ch & 7; *(LAS u32x4*)(Kc + row * 72 + cc * 8) = *(const u32x4*)(KC + ((size_t)bg * 128 + row) * 64 + cc * 8); }
      for (int ch = tid; ch < 64 * 16; ch += 512) { const int row = ch >> 4, cc = ch & 15; *(LAS u32x4*)(Vc + row * 136 + cc * 8) = *(const u32x4*)(VTC + ((size_t)bg * 64 + row) * 128 + cc * 8); }
      last_bg = bg; }
    if (tid == 0) SEL[32] = 0u;
    bf16x8 qf[2][1][2]; int tq[2][1];
#pragma unroll
    for (int s = 0; s < 2; ++s) {
      tq[s][0] = t0 + 4 * wv + 2 * s + tokl;
      const size_t tok = (size_t)b * SEQ + tq[s][0];
#pragma unroll
      for (int ks = 0; ks < 2; ++ks) qf[s][0][ks] = *(const bf16x8*)(Qb + tok * 1024 + head * 64 + ks * 32 + g4 * 8);
    }
    __syncthreads();
    {
    const int tlc = otid(); const int r = tlc & 15, g4 = (tlc >> 4) & 3, lane = tlc & 63, tokl = r >> 3, hl = r & 7;
#pragma unroll
    for (int s = 0; s < 2; ++s) {
      f32x4 oc[4];
#pragma unroll
      for (int dt = 0; dt < 4; ++dt) oc[dt] = (f32x4){0.f, 0.f, 0.f, 0.f};
      f32x4 sc[8];
#pragma unroll
      for (int kt = 0; kt < 8; ++kt) {
        sc[kt] = (f32x4){0.f, 0.f, 0.f, 0.f};
#pragma unroll
        for (int ks = 0; ks < 2; ++ks) {
          const bf16x8 kf = *(const LAS bf16x8*)(Kc + (kt * 16 + r) * 72 + ks * 32 + g4 * 8);
          sc[kt] = MFMA16(kf, qf[s][0][ks], sc[kt]);
        }
      }
      float mx = -1e30f;
#pragma unroll
      for (int kt = 0; kt < 8; ++kt)
#pragma unroll
        for (int i = 0; i < 4; ++i) {
          const int n = kt * 16 + g4 * 4 + i;
          const bool valid = (16 * n + 31 <= tq[s][0]) && (n < 127);
          const float sv = valid ? sc[kt][i] : -1e30f;
          sc[kt][i] = sv; mx = fmaxf(mx, sv);
        }
      mx = fmaxf(mx, __shfl_xor(mx, 16)); mx = fmaxf(mx, __shfl_xor(mx, 32));
      float rsum = 0.f;
#pragma unroll
      for (int kt = 0; kt < 8; ++kt)
#pragma unroll
        for (int i = 0; i < 4; ++i) { const float sv = sc[kt][i]; const float pv = (sv > -1e29f) ? fast_exp2(sv - mx) : 0.f; sc[kt][i] = pv; rsum += pv; }
      rsum += __shfl_xor(rsum, 16); rsum += __shfl_xor(rsum, 32);
      const float inv = 1.f / fmaxf(rsum, 1e-20f);
      float prevb = 0.f;
#pragma unroll
      for (int kt = 0; kt < 8; ++kt) {
        sc[kt] = sc[kt] * inv;
        const float a = (sc[kt][0] + sc[kt][1]) + (sc[kt][2] + 0.5f * sc[kt][3]);
        const float bcur = 0.5f * sc[kt][3];
        const float up = __shfl(bcur, (lane + 48) & 63);
        const float wrap = __shfl(prevb, (lane + 48) & 63);
        float impv = a + (g4 > 0 ? up : wrap);
        impv += __shfl_xor(impv, 1); impv += __shfl_xor(impv, 2); impv += __shfl_xor(impv, 4);
        if (hl == 0) IMPF[(4 * wv + 2 * s + tokl) * 33 + kt * 4 + g4] = impv;
        prevb = bcur;
      }
#pragma unroll
      for (int k4 = 0; k4 < 4; ++k4) {
        u32x4 w; w.x = cvt_pk_v(sc[2 * k4][0], sc[2 * k4][1]); w.y = cvt_pk_v(sc[2 * k4][2], sc[2 * k4][3]);
        w.z = cvt_pk_v(sc[2 * k4 + 1][0], sc[2 * k4 + 1][1]); w.w = cvt_pk_v(sc[2 * k4 + 1][2], sc[2 * k4 + 1][3]);
        const bf16x8 pb = __builtin_bit_cast(bf16x8, w);
#pragma unroll
        for (int dt = 0; dt < 4; ++dt) {
          const LAS bf16_t* vp = Vc + (dt * 16 + r) * 136 + k4 * 32 + 4 * g4;
          const u32x2 lo2 = *(const LAS u32x2*)vp, hi2 = *(const LAS u32x2*)(vp + 16);
          u32x4 vv; vv.x = lo2.x; vv.y = lo2.y; vv.z = hi2.x; vv.w = hi2.y;
          oc[dt] = MFMA16(__builtin_bit_cast(bf16x8, vv), pb, oc[dt]);
        }
      }
      { const float g0 = GT[((size_t)b * SEQ + tq[s][0]) * 48 + head * 3 + 0];
        float* yf = YF + ((size_t)b * SEQ + tq[s][0]) * 1024 + head * 64 + g4 * 4;
#pragma unroll
        for (int dt = 0; dt < 4; ++dt) *(f32x4*)(yf + dt * 16) = oc[dt] * g0; }
      asm volatile("" ::: "memory");
    }
    }
    __syncthreads();
    for (int idx = tid; idx < TQ * 32; idx += 512) {
      const int q = idx >> 5, j = idx & 31, t = t0 + q, cur = t >> 6;
      const bool forced = (j == 0) || (j == cur) || (j == cur - 1), causal = (j <= cur), cand = causal && !forced;
      const float my = IMPF[q * 33 + j];
      int rank = 0;
#pragma unroll
      for (int jj = 0; jj < 32; ++jj) {
        const float vv = IMPF[q * 33 + jj];
        const bool cj = (jj <= cur) && !((jj == 0) || (jj == cur) || (jj == cur - 1));
        rank += (cj && (vv > my || (vv == my && jj < j))) ? 1 : 0;
      }
      const bool sbit = causal && (forced || cur < 8 || (cand && rank < 5));
      const unsigned long long bal = __ballot(sbit);
      if ((lane & 31) == 0) { const unsigned sl = (lane == 0) ? (unsigned)bal : (unsigned)(bal >> 32); SEL[q] = sl; __hip_atomic_fetch_or(&SEL[32], sl, __ATOMIC_RELAXED, __HIP_MEMORY_SCOPE_WORKGROUP); }
    }
    __syncthreads();
    unsigned sel[2][1];
#pragma unroll
    for (int s = 0; s < 2; ++s) sel[s][0] = SEL[4 * wv + 2 * s + tokl];
    const unsigned uni = (unsigned)__builtin_amdgcn_readfirstlane((int)SEL[32]);
    const int tmA = t0 + 4 * wv, tmB = tmA + 2;
    {
      f32x4 oA[1][4], oB[1][4]; float mA[1] = {-1e30f}, lA[1] = {0.f}, mB[1] = {-1e30f}, lB[1] = {0.f};
#pragma unroll
      for (int dt = 0; dt < 4; ++dt) { oA[0][dt] = (f32x4){0.f, 0.f, 0.f, 0.f}; oB[0][dt] = (f32x4){0.f, 0.f, 0.f, 0.f}; }
      attn_loop_pair<1>(oA, mA, lA, qf[0], tq[0], sel[0], tmA, tmA + 1, oB, mB, lB, qf[1], tq[1], sel[1], tmB, tmB + 1,
                        uni, KS + (size_t)bg * SEQ * 64, 64, VTS + (size_t)bg * 64 * SEQ, SEQ, Kl, Vl);
      const float sA = GT[((size_t)b * SEQ + tq[0][0]) * 48 + head * 3 + 1] / fmaxf(lA[0], 1e-20f), sB = GT[((size_t)b * SEQ + tq[1][0]) * 48 + head * 3 + 1] / fmaxf(lB[0], 1e-20f);
      float* yfA = YF + ((size_t)b * SEQ + tq[0][0]) * 1024 + head * 64 + g4 * 4; float* yfB = YF + ((size_t)b * SEQ + tq[1][0]) * 1024 + head * 64 + g4 * 4;
#pragma unroll
      for (int dt = 0; dt < 4; ++dt) { *(f32x4*)(yfA + dt * 16) = *(const f32x4*)(yfA + dt * 16) + oA[0][dt] * sA; *(f32x4*)(yfB + dt * 16) = *(const f32x4*)(yfB + dt * 16) + oB[0][dt] * sB; }
    }
    {
      f32x4 oA[1][4], oB[1][4]; float mA[1] = {-1e30f}, lA[1] = {0.f}, mB[1] = {-1e30f}, lB[1] = {0.f};
#pragma unroll
      for (int dt = 0; dt < 4; ++dt) { oA[0][dt] = (f32x4){0.f, 0.f, 0.f, 0.f}; oB[0][dt] = (f32x4){0.f, 0.f, 0.f, 0.f}; }
      const int jlo = (t0 - 511 > 0 ? t0 - 511 : 0) >> 6, jhi = (t0 + TQ - 1) >> 6;
      const unsigned remw = ((2u << jhi) - 1u) & ~((1u << jlo) - 1u);
      attn_loop_pair<2>(oA, mA, lA, qf[0], tq[0], sel[0], tmA, tmA + 1, oB, mB, lB, qf[1], tq[1], sel[1], tmB, tmB + 1,
                        remw, KW + (size_t)bg * SEQ * 64, 64, VTW + (size_t)bg * 64 * SEQ, SEQ, Kl, Vl);
      const float sA = GT[((size_t)b * SEQ + tq[0][0]) * 48 + head * 3 + 2] / fmaxf(lA[0], 1e-20f), sB = GT[((size_t)b * SEQ + tq[1][0]) * 48 + head * 3 + 2] / fmaxf(lB[0], 1e-20f);
      const float* yfA = YF + ((size_t)b * SEQ + tq[0][0]) * 1024 + head * 64 + g4 * 4; const float* yfB = YF + ((size_t)b * SEQ + tq[1][0]) * 1024 + head * 64 + g4 * 4;
      bf16_t* dA = YB + ((size_t)b * SEQ + tq[0][0]) * 1024 + head * 64 + g4 * 4; bf16_t* dB = YB + ((size_t)b * SEQ + tq[1][0]) * 1024 + head * 64 + g4 * 4;
#pragma unroll
      for (int dt = 0; dt < 4; ++dt) {
        const f32x4 va = *(const f32x4*)(yfA + dt * 16) + oA[0][dt] * sA, vb = *(const f32x4*)(yfB + dt * 16) + oB[0][dt] * sB;
        u32x2 wa; wa.x = cvt_pk_bf16(va[0], va[1]); wa.y = cvt_pk_bf16(va[2], va[3]); *(u32x2*)(dA + dt * 16) = wa;
        u32x2 wb; wb.x = cvt_pk_bf16(vb[0], vb[1]); wb.y = cvt_pk_bf16(vb[2], vb[3]); *(u32x2*)(dB + dt * 16) = wb;
      }
    }
    __syncthreads();
  }
#undef Qb
#undef KC
#undef VTC
#undef KS
#undef VTS
#undef KW
#undef VTW
#undef GT
#undef YB
#undef YF
}

#define XB_TMO      128
#define XB_XCNT(j)  (256  + 64 * (j))
#define XB_XSUB(j)  (1280 + 64 * (j))
#define XB_XGEN(j)  (2304 + 64 * (j))
#define XB_TOP      3328
#define XB_TOPGEN   3392
#define XB_SPIN_CAP (1u << 22)
DI unsigned xb_ld(unsigned* p)              { return __hip_atomic_load(p, __ATOMIC_RELAXED, __HIP_MEMORY_SCOPE_AGENT); }
DI unsigned xb_add(unsigned* p, unsigned v) { return __hip_atomic_fetch_add(p, v, __ATOMIC_RELAXED, __HIP_MEMORY_SCOPE_AGENT); }
DI unsigned xb_xcc_id() { return (unsigned)__builtin_amdgcn_s_getreg((3 << 11) | 20) & 0xFu; }
#define XB_SPIN(cond, bar) do { unsigned _sp = 0; while (cond) { __builtin_amdgcn_s_sleep(1); \
    if ((++_sp & 255u) == 0u) { if (xb_ld(&(bar)[XB_TMO])) break; if (_sp > XB_SPIN_CAP) { atomicAdd(&(bar)[XB_TMO], 1u); break; } } } } while (0)
DI void xcd_barrier_complete(unsigned* bar, unsigned x, unsigned& nloc, unsigned& nx) {
    const unsigned G = gridDim.x * gridDim.y * gridDim.z;
    unsigned sum, cnt, mine, sp = 0u;
    for (;;) {
        sum = 0u; cnt = 0u; mine = 0u;
#pragma unroll
        for (unsigned j = 0; j < 16; ++j) { const unsigned c = xb_ld(&bar[XB_XCNT(j)]); sum += c; cnt += (c > 0u) ? 1u : 0u; mine = (j == x) ? c : mine; }
        if (sum == G) break;
        __builtin_amdgcn_s_sleep(1);
        if ((++sp & 255u) == 0u) { if (xb_ld(&bar[XB_TMO])) break; if (sp > XB_SPIN_CAP) { atomicAdd(&bar[XB_TMO], 1u); break; } }
    }
    nloc = mine > 0u ? mine : 1u; nx = cnt > 0u ? cnt : 1u;
}
DI void xcd_barrier(unsigned* bar, volatile LAS unsigned* st) {
    asm volatile("s_waitcnt vmcnt(0)" ::: "memory");
    __syncthreads();
    if (threadIdx.x == 0) {
        const unsigned x = xb_xcc_id();
        __builtin_amdgcn_s_waitcnt(0);
        unsigned nloc = st[0], nx = st[1];
        if (nloc == 0u) { xcd_barrier_complete(bar, x, nloc, nx); st[0] = nloc; st[1] = nx; }
        const unsigned old = xb_add(&bar[XB_XSUB(x)], 1u);
        const unsigned gen = old / nloc;
        if (old + 1u == (gen + 1u) * nloc) {
            __builtin_amdgcn_fence(__ATOMIC_RELEASE, "agent");
            asm volatile("s_waitcnt vmcnt(0)" ::: "memory");
            const unsigned og = xb_add(&bar[XB_TOP], 1u);
            const unsigned tg = og / nx;
            if (og + 1u == (tg + 1u) * nx) xb_add(&bar[XB_TOPGEN], 1u);
            else XB_SPIN(xb_ld(&bar[XB_TOPGEN]) == tg, bar);
            __builtin_amdgcn_fence(__ATOMIC_ACQUIRE, "agent");
            xb_add(&bar[XB_XGEN(x)], 1u);
            asm volatile("s_waitcnt vmcnt(0)" ::: "memory");
        } else {
            XB_SPIN(xb_ld(&bar[XB_XGEN(x)]) == gen, bar);
            __builtin_amdgcn_fence(__ATOMIC_ACQUIRE, "agent");
            asm volatile("s_waitcnt vmcnt(0)" ::: "memory");
        }
    }
    __syncthreads();
}

template <class Epi> DI void run_gemm(LAS unsigned char* lds, const bf16_t* A, int lda, const bf16_t* Bt, int M, int N, int K, const Epi& E, int crot = 0, int ldb = 0) {
  if (ldb == 0) ldb = K;
  asm volatile("" : "+s"(K), "+s"(lda), "+s"(N), "+s"(M), "+s"(ldb));
  pg8::Gemm g{A, Bt, M, N, K, lda, ldb};
  pg8::StaticOrder S; S.init(M, N, (int)gridDim.x, (int)((blockIdx.x + gridDim.x - crot) % gridDim.x));
  pg8::gemm_phase<Epi, pg8::StaticOrder, true, true>(lds, g, S, E);
}

#ifndef PHMASK
#define PHMASK 0xffffffffu
#endif
#define PH(k) ((PHMASK >> (k)) & 1u)
#ifndef DBLMASK
#define DBLMASK 0u
#endif
#define REP(k) for (int r_ = 0; r_ < 1 + (int)((DBLMASK >> (k)) & 1u); ++r_)
#ifndef EXTRA_SYNCS
#define EXTRA_SYNCS 0
#endif
typedef const __attribute__((address_space(4))) Params* KP;
DI KP kparams() { KP kp = (KP)__builtin_amdgcn_kernarg_segment_ptr(); asm volatile("" : "+s"(kp)); return kp; }
#define WSP(type, off) ((type*)(kparams()->ws + (off)))
#define MODL(l) (WSP(float, WS_MOD) + (size_t)(l) * NB * NMOD)
#define XB_ST ((volatile LAS unsigned*)(lds + LDS_BYTES - 64))
#ifndef USE_CG_SYNC
#define GSYNC() xcd_barrier(WSP(unsigned, WS_BAR), XB_ST)
#else
#define GSYNC() grid.sync()
#endif

DI void conv_layer(int L, int part, LAS float* tile, int Gp, int bidp) {
  int rot = 0;
  const int i0 = 2 * L, m = L >> 1;
  if (part == 0) {
    prep_transpose<1, 256, true>(kparams()->ff_w13 + (size_t)i0 * D * 2 * DFF, D, 2 * DFF, WSP(bf16_t, WS_WT13) + (size_t)i0 * 2 * DFF * D, 2 * DFF, tile, rot, Gp, bidp);
    prep_transpose<0, 256, true>(kparams()->ff_w2 + (size_t)i0 * DFF * D, DFF, D, WSP(bf16_t, WS_WT2) + (size_t)i0 * D * DFF, D, tile, rot, Gp, bidp);
    prep_transpose<0, 256, true>(kparams()->ff_w2 + (size_t)(i0 + 1) * DFF * D, DFF, D, WSP(bf16_t, WS_WT2) + (size_t)(i0 + 1) * D * DFF, D, tile, rot, Gp, bidp);
  } else {
    prep_transpose<1, 256, true>(kparams()->ff_w13 + (size_t)(i0 + 1) * D * 2 * DFF, D, 2 * DFF, WSP(bf16_t, WS_WT13) + (size_t)(i0 + 1) * 2 * DFF * D, 2 * DFF, tile, rot, Gp, bidp);
    if ((L & 1) == 0) {
      prep_transpose<0, 256, true>(kparams()->hy_w_in + (size_t)m * D * HY_IN, D, HY_IN, WSP(bf16_t, WS_WTHI) + (size_t)m * 2048 * D, 2048, tile, rot, Gp, bidp);
      prep_transpose<2, 256, false>(kparams()->hy_w_uq + (size_t)m * 256 * 768, 256, 768, WSP(bf16_t, WS_WTUQ) + (size_t)m * 768 * 256, 768, tile, rot, Gp, bidp);
      prep_transpose<0, 128, true>(kparams()->hy_w_ukv + (size_t)m * 128 * 1024, 128, 1024, WSP(bf16_t, WS_WTUKV) + (size_t)m * 1024 * 128, 1024, tile, rot, Gp, bidp);
      prep_transpose<0, 256, true>(kparams()->hy_w_out + (size_t)m * D * D, D, D, WSP(bf16_t, WS_WTHO) + (size_t)m * D * D, D, tile, rot, Gp, bidp);
    } else {
      prep_transpose<0, 256, true>(kparams()->nsa_w_in + (size_t)m * D * NSA_IN, D, NSA_IN, WSP(bf16_t, WS_WTNI) + (size_t)m * 2048 * D, 2048, tile, rot, Gp, bidp);
      prep_transpose<0, 256, true>(kparams()->nsa_w_out + (size_t)m * D * D, D, D, WSP(bf16_t, WS_WTNO) + (size_t)m * D * D, D, tile, rot, Gp, bidp);
      for (int kind = 0; kind < 2; ++kind)
        prep_transpose<0, 256, true>(kparams()->nsa_cmp_w1 + (size_t)(m * 2 + kind) * 2048 * 128, 2048, 128, WSP(bf16_t, WS_WTC1) + (size_t)(m * 2 + kind) * 256 * 2048, 256, tile, rot, Gp, bidp);
    }
  }
}
__global__ void __launch_bounds__(512, 2) mega(Params p_unused) {
  extern __shared__ __attribute__((aligned(16))) unsigned char lds_raw[];
  LAS unsigned char* lds = (LAS unsigned char*)lds_raw;
  cg::grid_group grid = cg::this_grid();
  { unsigned* bar0 = WSP(unsigned, WS_BAR);
    if (blockIdx.x == 0) for (int i = threadIdx.x; i < (int)(BAR_BYTES / 4); i += 512) bar0[i] = 0u;
    if (threadIdx.x == 0) { XB_ST[0] = 0u; XB_ST[1] = 0u; } }
  __syncthreads();

  REP(0) if (PH(0)) {
    LAS float* tile = (LAS float*)lds;
    int rot = 0;
    (void)rot;
    conv_layer(0, 0, tile, 0, 0); conv_layer(0, 1, tile, 0, 0);
    prep_adaln(kparams()->c, kparams()->ada_w, kparams()->ada_b, WSP(float, WS_MOD), tile);
    prep_misc(kparams()->positions, kparams()->nsa_cmp_pe, kparams()->nsa_cmp_w1, WSP(float, WS_ROPE), WSP(float, WS_ROPE) + (size_t)T * 16, WSP(float, WS_CBIAS), tile);
  }
  grid.sync();
  { unsigned* bar0 = WSP(unsigned, WS_BAR);
    if (threadIdx.x == 0) (void)xb_add(&bar0[XB_XCNT(xb_xcc_id())], 1u); }

  for (int l = 0; l < NLAYER; ++l) {
    const int mi = l >> 1;
    for (int sub = 0; sub < 3; ++sub) {
      const bool first = (l == 0 && sub == 0);
      REP(1) if (PH(1)) { const float* xin = first ? kparams()->x : WSP(float, WS_X);
        norm_phase<0>(xin, kparams()->norm_g + (size_t)(l * 3 + sub) * D, MODL(l) + (3 * sub) * D, MODL(l) + (3 * sub + 1) * D, WSP(bf16_t, WS_HB), nullptr); }
      GSYNC();
      if (sub != 1) {
        const int f = l * 2 + (sub >> 1);
        REP(2) if (PH(2)) { EpiSwiglu E{WSP(bf16_t, WS_UB)}; run_gemm(lds, WSP(bf16_t, WS_HB), D, WSP(bf16_t, WS_WT13) + (size_t)f * 2 * DFF * D, T, 2 * DFF, D, E);
          if (l + 1 < NLAYER) {
            const int Gn = (int)gridDim.x, extra = (64 * 22) % Gn, cb = (int)blockIdx.x;
            if (extra == 0) conv_layer(l + 1, sub >> 1, (LAS float*)lds, 0, 0);
            else if (cb >= extra) conv_layer(l + 1, sub >> 1, (LAS float*)lds, Gn - extra, cb - extra);
          } }
        GSYNC();
        REP(3) if (PH(3)) { const float* xin = first ? kparams()->x : WSP(float, WS_X);
          EpiResid E{xin, (r_ == (int)((DBLMASK >> 3) & 1u)) ? WSP(float, WS_X) : WSP(float, WS_YF), MODL(l) + (3 * sub + 2) * D, 0.5f}; run_gemm(lds, WSP(bf16_t, WS_UB), DFF, WSP(bf16_t, WS_WT2) + (size_t)f * D * DFF, T, D, DFF, E); }
        GSYNC();
      } else if ((l & 1) == 0) {
        REP(4) if (PH(4)) { EpiPlain E{WSP(bf16_t, WS_Z), 2048}; run_gemm(lds, WSP(bf16_t, WS_HB), D, WSP(bf16_t, WS_WTHI) + (size_t)mi * 2048 * D, T, 2048, D, E); }
        GSYNC();
        REP(5) if (PH(5)) mla_prep_phase(WSP(bf16_t, WS_Z), kparams()->hy_conv_w + (size_t)mi * 3 * 512, kparams()->hy_q_norm + mi * 256, kparams()->hy_kv_norm + mi * 128,
                                  WSP(float, WS_ROPE), WSP(float, WS_ROPE) + (size_t)T * 16, WSP(bf16_t, WS_YB), WSP(bf16_t, WS_CQ), WSP(bf16_t, WS_CKV), WSP(bf16_t, WS_KB));
        GSYNC();
        REP(6) if (PH(6)) { EpiQRope E{WSP(bf16_t, WS_QB), WSP(float, WS_ROPE), WSP(float, WS_ROPE) + (size_t)T * 16, 0.10206207261596575f * LOG2E};
          run_gemm(lds, WSP(bf16_t, WS_CQ), 256, WSP(bf16_t, WS_WTUQ) + (size_t)mi * 768 * 256, T, 768, 256, E); }
        REP(7) if (PH(7)) { EpiMlaKV E{WSP(bf16_t, WS_KB), WSP(bf16_t, WS_VT)}; run_gemm(lds, WSP(bf16_t, WS_CKV), 128, WSP(bf16_t, WS_WTUKV) + (size_t)mi * 1024 * 128, T, 1024, 128, E); }
        GSYNC();
        REP(8) if (PH(8)) mla_attn_phase(WSP(bf16_t, WS_QB), WSP(bf16_t, WS_KB), WSP(bf16_t, WS_VT), WSP(bf16_t, WS_YB), lds);
        GSYNC();
        REP(9) if (PH(9)) { EpiResid E{WSP(float, WS_X), (r_ == (int)((DBLMASK >> 9) & 1u)) ? WSP(float, WS_X) : WSP(float, WS_YF), MODL(l) + 5 * D, 1.0f}; run_gemm(lds, WSP(bf16_t, WS_YB), D, WSP(bf16_t, WS_WTHO) + (size_t)mi * D * D, T, D, D, E); }
        GSYNC();
      } else {
        REP(10) if (PH(10)) { EpiNsaIn E{WSP(bf16_t, WS_QB), WSP(bf16_t, WS_KVC), WSP(bf16_t, WS_KS), WSP(bf16_t, WS_VTS), WSP(bf16_t, WS_KW), WSP(bf16_t, WS_VTW), WSP(float, WS_GT),
                                 kparams()->nsa_gate_b + mi * 48, 0.125f * LOG2E};
          run_gemm(lds, WSP(bf16_t, WS_HB), D, WSP(bf16_t, WS_WTNI) + (size_t)mi * 2048 * D, T, 2048, D, E); }
        GSYNC();
        REP(11) if (PH(11)) for (int kc = 0; kc < 16; ++kc) {
          const int kind = kc >> 3, ch = kc & 7;
          EpiCmp E{WSP(float, WS_CH) + (size_t)kc * 2048 * 128};
          run_gemm(lds, WSP(bf16_t, WS_KVC) + (size_t)kind * T * 128 + ch * 256, 1024, WSP(bf16_t, WS_WTC1) + (size_t)(mi * 2 + kind) * 256 * 2048 + ch * 256, 2048, 256, 256, E, kc * 8, 2048);
        }
        GSYNC();
        REP(12) if (PH(12)) nsa_cmp2_phase(WSP(float, WS_CH), WSP(float, WS_CBIAS) + mi * 2 * 16 * 128, kparams()->nsa_cmp_w2 + (size_t)mi * 2 * 128 * 64, WSP(bf16_t, WS_KC), WSP(bf16_t, WS_VTC), (LAS float*)lds);
        GSYNC();
#ifndef NSA_PAIR
#define NSA_PAIR 1
#endif
        REP(13) if (PH(13)) { if (NSA_PAIR) nsa_attn_phase2(kparams()->ws, lds); else nsa_attn_phase(kparams()->ws, lds); }
        GSYNC();
        REP(14) if (PH(14)) { EpiResid E{WSP(float, WS_X), (r_ == (int)((DBLMASK >> 14) & 1u)) ? WSP(float, WS_X) : WSP(float, WS_YF), MODL(l) + 5 * D, 1.0f}; run_gemm(lds, WSP(bf16_t, WS_YB), D, WSP(bf16_t, WS_WTNO) + (size_t)mi * D * D, T, D, D, E); }
        GSYNC();
      }
    }
  }
  for (int e_ = 0; e_ < EXTRA_SYNCS; ++e_) GSYNC();
  if (PH(15)) norm_phase<1>(WSP(float, WS_X), kparams()->final_g, nullptr, nullptr, nullptr, kparams()->out);
}

extern "C" void kernel_launch(void* const* d_in, const int* in_sizes, int n_in, void* d_out, int out_size, void* d_ws, size_t ws_size, hipStream_t stream) {
  static int grid = 0;
  if (grid == 0) {
    int dev = 0, cus = 0, per_cu = 0;
    if (hipGetDevice(&dev) != hipSuccess || hipDeviceGetAttribute(&cus, hipDeviceAttributeMultiprocessorCount, dev) != hipSuccess) { fprintf(stderr, "device query failed\n"); grid = -1; return; }
    if (hipFuncSetAttribute((const void*)mega, hipFuncAttributeMaxDynamicSharedMemorySize, LDS_BYTES) != hipSuccess) { fprintf(stderr, "hipFuncSetAttribute failed\n"); grid = -1; return; }
    if (hipOccupancyMaxActiveBlocksPerMultiprocessor(&per_cu, (const void*)mega, 512, LDS_BYTES) != hipSuccess || per_cu < 1) { fprintf(stderr, "occupancy query: %d\n", per_cu); }
    (void)hipGetLastError();
    if (ws_size < WS_END) { fprintf(stderr, "workspace too small: %zu < %zu\n", ws_size, (size_t)WS_END); grid = -1; return; }
    grid = cus;
  }
  if (grid < 0) return;
  Params p{};
  p.x = (const float*)d_in[0]; p.c = (const float*)d_in[1]; p.positions = (const int*)d_in[2]; p.ada_w = (const float*)d_in[3]; p.ada_b = (const float*)d_in[4];
  p.norm_g = (const float*)d_in[5]; p.final_g = (const float*)d_in[6]; p.ff_w13 = (const float*)d_in[7]; p.ff_w2 = (const float*)d_in[8]; p.hy_w_in = (const float*)d_in[9];
  p.hy_conv_w = (const float*)d_in[10]; p.hy_q_norm = (const float*)d_in[11]; p.hy_kv_norm = (const float*)d_in[12]; p.hy_w_uq = (const float*)d_in[13];
  p.hy_w_ukv = (const float*)d_in[14]; p.hy_w_out = (const float*)d_in[15]; p.nsa_w_in = (const float*)d_in[16]; p.nsa_cmp_pe = (const float*)d_in[17];
  p.nsa_cmp_w1 = (const float*)d_in[18]; p.nsa_cmp_w2 = (const float*)d_in[19]; p.nsa_gate_b = (const float*)d_in[20]; p.nsa_w_out = (const float*)d_in[21];
  p.out = (float*)d_out; p.ws = (unsigned char*)d_ws;
  void* args[] = {&p};
  hipError_t e = hipLaunchCooperativeKernel((const void*)mega, dim3(grid), dim3(512), args, LDS_BYTES, stream);
  if (e != hipSuccess) fprintf(stderr, "cooperative launch failed: %s (grid %d)\n", hipGetErrorString(e), grid);
}
```

```cpp
#include <hip/hip_runtime.h>
#include <hip/hip_cooperative_groups.h>
#include <cstdio>
#include <cstdint>
namespace cg = cooperative_groups;
namespace pg8 {
#define PG8_LAS __attribute__((address_space(3)))
typedef unsigned short bf16_t;
typedef short bf16x8 __attribute__((ext_vector_type(8)));
typedef float f32x4 __attribute__((ext_vector_type(4)));
typedef unsigned u32x4 __attribute__((ext_vector_type(4)));
constexpr int BM = 256, BK = 64, HALF = 128, HTB = HALF * BK * 2  , STAGE_BYTES = 8 * HTB, NXCD = 8, WGM = 8;

__host__ __device__ __forceinline__ int lds_byte(int r, int c) { const int st = (r >> 4) * 2 + (c >> 5), rr = r & 15, cc = c & 31, ob = rr * 64 + cc * 2; return st * 1024 + (ob ^ (((ob >> 9) & 1) << 5)); }
__host__ __device__ __forceinline__ void stage_rc(int b, int& R, int& C) { const int st = b / 1024, sb = b % 1024, swz = sb ^ (((sb >> 9) & 1) << 5); R = (st >> 1) * 16 + swz / 64; C = (st & 1) * 32 + (swz % 64) / 2; }
__host__ __device__ __forceinline__ int perm32(int rho) { const int n = rho >> 4, i = rho & 15; return 8 * (i >> 2) + 4 * n + (i & 3); }

struct Unit { int pm, pn; };
struct Gemm { const bf16_t* A; const bf16_t* Bt; int M, N, K, lda, ldb; };

struct StaticOrder {
    int nM, nN, nwg, G, c;
    __host__ __device__ void init(int M, int N, int G_, int c_) { nM = M / BM; nN = N / BM; nwg = nM * nN; G = G_; c = c_; }
    __host__ __device__ bool next(int i, Unit& u) const {
        const long L = (long)i * G + c; if (L >= nwg) return false;
        int wgid = (int)L; { const int q = nwg / NXCD, r = nwg % NXCD, xcd = wgid % NXCD, off = wgid / NXCD; wgid = (xcd < r ? xcd * (q + 1) : r * (q + 1) + (xcd - r) * q) + off; }
        const int nig = WGM * nN, gid = wgid / nig, fm = gid * WGM, gsz = (nM - fm) < WGM ? (nM - fm) : WGM;
        u.pm = fm + ((wgid % nig) % gsz); u.pn = (wgid % nig) / gsz; return true;
    }
    __device__ __forceinline__ void a_ready(const Unit&) const {}
    __device__ __forceinline__ void done(const Unit&) const {}
};

__device__ __forceinline__ unsigned cvt_pk_bf16(float lo, float hi) { unsigned r; asm volatile("v_cvt_pk_bf16_f32 %0, %1, %2" : "=v"(r) : "v"(lo), "v"(hi)); return r; }

template <class Epi, class Sched, bool ALIGN_EPI = false, bool SP2 = false>
__device__ __forceinline__ void gemm_phase(PG8_LAS unsigned char* lds, const Gemm g, const Sched& S, const Epi& E) {
    int tid_ = threadIdx.x; asm volatile("" : "+v"(tid_));
    const int tid = tid_, wid = __builtin_amdgcn_readfirstlane(tid >> 6), lane = tid & 63, wr = wid >> 2, wc = wid & 3, fr = lane & 15, fq = lane >> 4;
    const int K = g.K, nt = K / BK;
    unsigned voffA[2], voffB[2];
#pragma unroll
    for (int i = 0; i < 2; ++i) { int R, C; stage_rc(tid * 16 + i * 8192, R, C); const int Rb = Epi::PERM ? ((R & ~31) + perm32(R & 31)) : R;
        voffA[i] = (unsigned)(R * g.lda + C) * 2u; voffB[i] = (unsigned)(Rb * g.ldb + C) * 2u; }
    const size_t kstep = (size_t)(BK * 2);
    const size_t hstep = (size_t)HALF * g.ldb * 2;
    const size_t tstep = 2 * hstep; const size_t hstepA = (size_t)HALF * g.lda * 2; const size_t tstepA = 2 * hstepA;
    const unsigned ldsw = (unsigned)wid * 1024u;
    const int aoff = lds_byte(wr * 64 + fr, fq * 8), boff = lds_byte(wc * 32 + fr, fq * 8);
#define PG8_SA(b, h) (((b) * 2 + (h)) * HTB)
#define PG8_SB(b, h) ((4 + (b) * 2 + (h)) * HTB)
#define PG8_STAGE(bufoff, gbase, voff) do { _Pragma("unroll") for (int _i = 0; _i < 2; ++_i) \
        __builtin_amdgcn_global_load_lds((const unsigned*)((const char*)(gbase) + (voff)[_i]), (PG8_LAS unsigned*)(lds + (bufoff) + ldsw + _i * 8192), 16, 0, 0); } while (0)
#define PG8_LDA(dst, b, h) do { _Pragma("unroll") for (int m = 0; m < 4; ++m) _Pragma("unroll") for (int k = 0; k < 2; ++k) dst[m][k] = *(const PG8_LAS bf16x8*)(lds + PG8_SA(b, h) + aoff + m * 2048 + k * 1024); } while (0)
#define PG8_LDB(dst, b, h) do { _Pragma("unroll") for (int n = 0; n < 2; ++n) _Pragma("unroll") for (int k = 0; k < 2; ++k) dst[n][k] = *(const PG8_LAS bf16x8*)(lds + PG8_SB(b, h) + boff + n * 2048 + k * 1024); } while (0)
#define PG8_MMA(ai, bj, At, Bt) do { __builtin_amdgcn_s_setprio(1); _Pragma("unroll") for (int m = 0; m < 4; ++m) _Pragma("unroll") for (int n = 0; n < 2; ++n) _Pragma("unroll") for (int k = 0; k < 2; ++k) \
        acc[ai][bj][m][n] = __builtin_amdgcn_mfma_f32_16x16x32_bf16(Bt[n][k], At[m][k], acc[ai][bj][m][n], 0, 0, 0); __builtin_amdgcn_s_setprio(0); } while (0)
#define PG8_WAIT_V(n) asm volatile("s_waitcnt vmcnt(" #n ")" ::: "memory")
#define PG8_WAIT_L(n) asm volatile("s_waitcnt lgkmcnt(" #n ")" ::: "memory")
#define PG8_BAR __builtin_amdgcn_s_barrier()
#define PG8_SCHED __builtin_amdgcn_sched_barrier(0)
    Unit cur, nxt; int ui = 0;
    if (!S.next(0, cur)) return;
    f32x4 acc[2][2][4][2];
#pragma unroll
    for (int a = 0; a < 2; ++a)
#pragma unroll
        for (int b = 0; b < 2; ++b)
#pragma unroll
            for (int m = 0; m < 4; ++m)
#pragma unroll
                for (int n = 0; n < 2; ++n) acc[a][b][m][n] = (f32x4){0.f, 0.f, 0.f, 0.f};
    bf16x8 At[4][2], B0[2][2], B1[2][2];
    const char* cA = (const char*)g.A + (size_t)cur.pm * tstepA; const char* cB = (const char*)g.Bt + (size_t)cur.pn * tstep;
    S.a_ready(cur);
    if constexpr (SP2) {
        PG8_STAGE(PG8_SB(0, 0), cB, voffB); PG8_STAGE(PG8_SB(0, 1), cB + hstep, voffB); PG8_STAGE(PG8_SA(0, 0), cA, voffA); PG8_STAGE(PG8_SA(0, 1), cA + hstepA, voffA);
        if (wr == 1) PG8_BAR;
        PG8_WAIT_V(2); PG8_BAR;
        PG8_STAGE(PG8_SB(1, 0), cB + kstep, voffB); PG8_STAGE(PG8_SA(1, 0), cA + kstep, voffA); PG8_STAGE(PG8_SB(1, 1), cB + hstep + kstep, voffB);
        PG8_WAIT_V(6); PG8_BAR;
    } else {
        PG8_STAGE(PG8_SB(0, 0), cB, voffB); PG8_STAGE(PG8_SA(0, 0), cA, voffA); PG8_STAGE(PG8_SB(0, 1), cB + hstep, voffB); PG8_STAGE(PG8_SA(0, 1), cA + hstepA, voffA);
        if (wr == 1) PG8_BAR;
        PG8_WAIT_V(4); PG8_BAR;
        PG8_STAGE(PG8_SB(1, 0), cB + kstep, voffB); PG8_STAGE(PG8_SA(1, 0), cA + kstep, voffA); PG8_STAGE(PG8_SB(1, 1), cB + hstep + kstep, voffB);
        PG8_WAIT_V(6); PG8_BAR;
    }
    for (;;) {
        const bool has_next = S.next(ui + 1, nxt);
        const char* nA = has_next ? (const char*)g.A + (size_t)nxt.pm * tstepA : cA; const char* nB = has_next ? (const char*)g.Bt + (size_t)nxt.pn * tstep : cB;
        for (int t = 0; t < nt; t += 2) {
            const bool last = (t == nt - 2);
            const char* a1 = cA + (size_t)(t + 1) * kstep;
            const char* a2 = last ? nA : cA + (size_t)(t + 2) * kstep; const char* b2 = last ? nB : cB + (size_t)(t + 2) * kstep;
            const char* a3 = a2 + kstep; const char* b3 = b2 + kstep;
            if (last && has_next) S.a_ready(nxt);
            if constexpr (SP2) {
            PG8_LDB(B0, 0, 0); PG8_LDB(B1, 0, 1); PG8_SCHED; PG8_LDA(At, 0, 0); PG8_STAGE(PG8_SA(1, 1), a1 + hstepA, voffA);
            PG8_WAIT_V(8); PG8_WAIT_L(0); PG8_BAR; PG8_MMA(0, 0, At, B0); PG8_MMA(0, 1, At, B1); PG8_BAR; PG8_SCHED;
            PG8_LDA(At, 0, 1); PG8_STAGE(PG8_SB(0, 0), b2, voffB); PG8_STAGE(PG8_SB(0, 1), b2 + hstep, voffB); PG8_STAGE(PG8_SA(0, 0), a2, voffA);
            PG8_WAIT_V(8); PG8_WAIT_L(0); PG8_BAR; PG8_MMA(1, 0, At, B0); PG8_MMA(1, 1, At, B1); PG8_BAR; PG8_SCHED;
            PG8_LDB(B0, 1, 0); PG8_LDB(B1, 1, 1); PG8_SCHED; PG8_LDA(At, 1, 0); PG8_STAGE(PG8_SA(0, 1), a2 + hstepA, voffA);
            PG8_WAIT_V(8); PG8_WAIT_L(0); PG8_BAR; PG8_MMA(0, 0, At, B0); PG8_MMA(0, 1, At, B1); PG8_BAR; PG8_SCHED;
            PG8_LDA(At, 1, 1); PG8_STAGE(PG8_SB(1, 0), b3, voffB); PG8_STAGE(PG8_SB(1, 1), b3 + hstep, voffB); PG8_STAGE(PG8_SA(1, 0), a3, voffA);
            PG8_WAIT_V(8); PG8_WAIT_L(0); PG8_BAR; PG8_MMA(1, 0, At, B0); PG8_MMA(1, 1, At, B1); PG8_BAR; PG8_SCHED;
            } else {
            PG8_LDB(B0, 0, 0); PG8_SCHED; PG8_LDA(At, 0, 0); PG8_STAGE(PG8_SA(1, 1), a1 + hstepA, voffA);
            PG8_WAIT_L(8); PG8_BAR; PG8_WAIT_L(0); PG8_MMA(0, 0, At, B0); PG8_BAR; PG8_SCHED;
            PG8_LDB(B1, 0, 1); PG8_STAGE(PG8_SB(0, 0), b2, voffB);
            PG8_BAR; PG8_WAIT_L(0); PG8_MMA(0, 1, At, B1); PG8_BAR;
            PG8_LDA(At, 0, 1); PG8_STAGE(PG8_SA(0, 0), a2, voffA);
            PG8_BAR; PG8_WAIT_L(0); PG8_MMA(1, 0, At, B0); PG8_BAR; PG8_SCHED;
            PG8_STAGE(PG8_SB(0, 1), b2 + hstep, voffB);
            PG8_WAIT_V(6); PG8_BAR; PG8_MMA(1, 1, At, B1); PG8_BAR;
            PG8_LDB(B0, 1, 0); PG8_SCHED; PG8_LDA(At, 1, 0); PG8_STAGE(PG8_SA(0, 1), a2 + hstepA, voffA);
            PG8_WAIT_L(8); PG8_BAR; PG8_WAIT_L(0); PG8_MMA(0, 0, At, B0); PG8_BAR; PG8_SCHED;
            PG8_LDB(B1, 1, 1); PG8_STAGE(PG8_SB(1, 0), b3, voffB);
            PG8_BAR; PG8_WAIT_L(0); PG8_MMA(0, 1, At, B1); PG8_BAR;
            PG8_LDA(At, 1, 1); PG8_STAGE(PG8_SA(1, 0), a3, voffA);
            PG8_BAR; PG8_WAIT_L(0); PG8_MMA(1, 0, At, B0); PG8_BAR; PG8_SCHED;
            PG8_STAGE(PG8_SB(1, 1), b3 + hstep, voffB);
            PG8_WAIT_V(6); PG8_BAR; PG8_MMA(1, 1, At, B1); PG8_BAR;
            }
        }
        if constexpr (ALIGN_EPI) { if (wr == 0) PG8_BAR; }
        if constexpr (!Epi::AFTER_DRAIN) { E(acc, cur, wr, wc, fr, fq); S.done(cur); }
        if (!has_next) break;
#pragma unroll
        for (int a = 0; a < 2; ++a)
#pragma unroll
            for (int b = 0; b < 2; ++b)
#pragma unroll
                for (int m = 0; m < 4; ++m)
#pragma unroll
                    for (int n = 0; n < 2; ++n) acc[a][b][m][n] = (f32x4){0.f, 0.f, 0.f, 0.f};
        cur = nxt; cA = nA; cB = nB; ++ui;
        if constexpr (ALIGN_EPI) { if (wr == 1) PG8_BAR; }
    }
    PG8_WAIT_V(0);
    if constexpr (!ALIGN_EPI) { if (wr == 0) PG8_BAR; }
    PG8_BAR;
    if constexpr (Epi::AFTER_DRAIN) { E.fused(acc, cur, wr, wc, fr, fq, lds, wid, lane); S.done(cur); }
#undef PG8_SA
#undef PG8_SB
#undef PG8_STAGE
#undef PG8_LDA
#undef PG8_LDB
#undef PG8_MMA
#undef PG8_WAIT_V
#undef PG8_WAIT_L
#undef PG8_BAR
#undef PG8_SCHED
}
}


#define DI __device__ __forceinline__
#define LAS __attribute__((address_space(3)))
using pg8::bf16_t; using pg8::bf16x8; using pg8::f32x4; using pg8::u32x4; using pg8::cvt_pk_bf16;
typedef short bf16x4 __attribute__((ext_vector_type(4)));
typedef unsigned u32x2 __attribute__((ext_vector_type(2)));

constexpr int NB = 8, SEQ = 2048, T = NB * SEQ, D = 1024, DFF = 2816, NLAYER = 4, NMOD = 9 * D;
constexpr int HY_IN = 1952, NSA_IN = 1840;
constexpr float EPS = 1e-6f;
constexpr float LOG2E = 1.4426950408889634f;
constexpr int LDS_BYTES = 147456;

constexpr size_t al256(size_t x) { return (x + 255) & ~(size_t)255; }
constexpr size_t WS_MOD   = 0;
constexpr size_t MOD_BYTES = (size_t)NLAYER * NB * NMOD * 4;
constexpr size_t WS_BAR   = WS_MOD + al256(MOD_BYTES);
constexpr size_t BAR_BYTES = 16384;
constexpr size_t ZERO_BYTES = al256(MOD_BYTES) + BAR_BYTES;
constexpr size_t WS_ROPE  = WS_BAR + BAR_BYTES;
constexpr size_t WS_CBIAS = WS_ROPE + al256((size_t)2 * T * 16 * 4);
constexpr size_t WS_WT13  = WS_CBIAS + al256(4 * 16 * 128 * 4);
constexpr size_t WS_WT2   = WS_WT13 + al256((size_t)8 * 5632 * 1024 * 2);
constexpr size_t WS_WTHI  = WS_WT2 + al256((size_t)8 * 1024 * 2816 * 2);
constexpr size_t WS_WTUQ  = WS_WTHI + al256((size_t)2 * 2048 * 1024 * 2);
constexpr size_t WS_WTUKV = WS_WTUQ + al256((size_t)2 * 768 * 256 * 2);
constexpr size_t WS_WTHO  = WS_WTUKV + al256((size_t)2 * 1024 * 128 * 2);
constexpr size_t WS_WTNI  = WS_WTHO + al256((size_t)2 * 1024 * 1024 * 2);
constexpr size_t WS_WTNO  = WS_WTNI + al256((size_t)2 * 2048 * 1024 * 2);
constexpr size_t WS_WTC1  = WS_WTNO + al256((size_t)2 * 1024 * 1024 * 2);
constexpr size_t WS_X     = WS_WTC1 + al256((size_t)4 * 256 * 2048 * 2);
constexpr size_t WS_HB    = WS_X + al256((size_t)T * D * 4);
constexpr size_t WS_UB    = WS_HB + al256((size_t)T * D * 2);
constexpr size_t WS_Z     = WS_UB + al256((size_t)T * DFF * 2);
constexpr size_t WS_CQ    = WS_Z + al256((size_t)T * 2048 * 2);
constexpr size_t WS_CKV   = WS_CQ + al256((size_t)T * 256 * 2);
constexpr size_t WS_QB    = WS_CKV + al256((size_t)T * 128 * 2);
constexpr size_t WS_KB    = WS_QB + al256((size_t)T * 1024 * 2);
constexpr size_t WS_VT    = WS_KB + al256((size_t)T * 768 * 2);
constexpr size_t WS_YB    = WS_VT + al256((size_t)T * 512 * 2);
constexpr size_t WS_KVC   = WS_YB + al256((size_t)T * 1024 * 2);
constexpr size_t WS_KS    = WS_KVC + al256((size_t)T * 256 * 2 + 8192);
constexpr size_t WS_VTS   = WS_KS + al256((size_t)T * 128 * 2);
constexpr size_t WS_KW    = WS_VTS + al256((size_t)T * 128 * 2);
constexpr size_t WS_VTW   = WS_KW + al256((size_t)T * 128 * 2);
constexpr size_t WS_GT    = WS_VTW + al256((size_t)T * 128 * 2);
constexpr size_t WS_CH    = WS_GT + al256((size_t)T * 48 * 4);
constexpr size_t WS_KC    = WS_CH + al256((size_t)16 * 2048 * 128 * 4);
constexpr size_t WS_VTC   = WS_KC + al256((size_t)16 * 128 * 64 * 2);
constexpr size_t WS_YF    = WS_VTC + al256((size_t)16 * 64 * 128 * 2);
constexpr size_t WS_END   = WS_YF + al256((size_t)T * 1024 * 4);

struct Params {
  const float* x; const float* c; const int* positions; const float* ada_w; const float* ada_b; const float* norm_g; const float* final_g;
  const float* ff_w13; const float* ff_w2; const float* hy_w_in; const float* hy_conv_w; const float* hy_q_norm; const float* hy_kv_norm;
  const float* hy_w_uq; const float* hy_w_ukv; const float* hy_w_out; const float* nsa_w_in; const float* nsa_cmp_pe; const float* nsa_cmp_w1;
  const float* nsa_cmp_w2; const float* nsa_gate_b; const float* nsa_w_out; float* out; unsigned char* ws;
};

DI int otid() { int t = threadIdx.x; asm volatile("" : "+v"(t)); return t; }
DI float wave_sum(float v) { v += __shfl_xor(v, 32); v += __shfl_xor(v, 16); v += __shfl_xor(v, 8); v += __shfl_xor(v, 4); v += __shfl_xor(v, 2); v += __shfl_xor(v, 1); return v; }
DI float bf2f(bf16_t h) { return __uint_as_float((unsigned)h << 16); }
DI float bflo(unsigned w) { return __uint_as_float(w << 16); }
DI float bfhi(unsigned w) { return __uint_as_float(w & 0xffff0000u); }
DI float fast_exp2(float x) { return __builtin_amdgcn_exp2f(x); }
DI float sigmoidf_(float x) { return __builtin_amdgcn_rcpf(1.f + __expf(-x)); }
DI float siluf_(float x) { return x * __builtin_amdgcn_rcpf(1.f + __expf(-x)); }
#define MFMA16(a, b, c) __builtin_amdgcn_mfma_f32_16x16x32_bf16((a), (b), (c), 0, 0, 0)

template <int MODE> DI int map_col(int n, int Nsrc) {
  if (MODE == 0) return n < Nsrc ? n : -1;
  if (MODE == 1) return ((n & 255) >> 7) * DFF + (n >> 8) * 128 + (n & 127);
  const int hh = n / 96, jj = n - hh * 96;
  return jj < 64 ? n : hh * 96 + 64 + ((jj - 64) & 1) * 16 + ((jj - 64) >> 1);
}
template <int MODE, int KT, bool VEC> DI void prep_transpose(const float* __restrict__ src, int K, int Nsrc, bf16_t* __restrict__ dst, int Ndst, LAS float* tile, int& rot) {
  const int G = gridDim.x, tid = otid();
  const int ntk = K / KT, nt = (Ndst >> 6) * ntk;
  int first = (int)blockIdx.x - rot; if (first < 0) first += G;
  if (VEC) {
    const int c4 = tid & 15, kr = tid >> 4;
    float4 v[KT / 32];
#define PT_LOAD(tt) do { const int tn_ = (tt) / ntk, tk_ = (tt) - tn_ * ntk; const int sc_ = map_col<MODE>(tn_ * 64 + c4 * 4, Nsrc); \
      _Pragma("unroll") for (int p = 0; p < KT / 32; ++p) v[p] = sc_ >= 0 ? *(const float4*)(src + (size_t)(tk_ * KT + p * 32 + kr) * Nsrc + sc_) : make_float4(0.f, 0.f, 0.f, 0.f); } while (0)
    if (first < nt) PT_LOAD(first);
    for (int t = first; t < nt; t += G) {
      const int tn = t / ntk, tk = t - tn * ntk, n0 = tn * 64, k0 = tk * KT;
#pragma unroll
      for (int p = 0; p < KT / 32; ++p) { LAS float* tp = tile + (p * 32 + kr) * 65 + c4 * 4; tp[0] = v[p].x; tp[1] = v[p].y; tp[2] = v[p].z; tp[3] = v[p].w; }
      __syncthreads();
      if (t + G < nt) PT_LOAD(t + G);
#pragma unroll
      for (int q = 0; q < KT / 64; ++q) {
        const int n = tid >> 3, kc = (tid & 7) + q * 8; float w8[8];
#pragma unroll
        for (int j = 0; j < 8; ++j) w8[j] = tile[(kc * 8 + j) * 65 + n];
        u32x4 w; w.x = cvt_pk_bf16(w8[0], w8[1]); w.y = cvt_pk_bf16(w8[2], w8[3]); w.z = cvt_pk_bf16(w8[4], w8[5]); w.w = cvt_pk_bf16(w8[6], w8[7]);
        *(u32x4*)(dst + (size_t)(n0 + n) * K + k0 + kc * 8) = w;
      }
      __syncthreads();
    }
#undef PT_LOAD
  } else {
  for (int t = first; t < nt; t += G) {
    const int tn = t / ntk, tk = t - tn * ntk, n0 = tn * 64, k0 = tk * KT;
    {
      const int kr = tid >> 6, nn = tid & 63; const int sc = map_col<MODE>(n0 + nn, Nsrc);
      float v[KT / 8];
#pragma unroll
      for (int p = 0; p < KT / 8; ++p) v[p] = sc >= 0 ? src[(size_t)(k0 + p * 8 + kr) * Nsrc + sc] : 0.f;
#pragma unroll
      for (int p = 0; p < KT / 8; ++p) tile[(p * 8 + kr) * 65 + nn] = v[p];
    }
    __syncthreads();
#pragma unroll
    for (int q = 0; q < KT / 64; ++q) {
      const int n = tid >> 3, kc = (tid & 7) + q * 8; float v[8];
#pragma unroll
      for (int j = 0; j < 8; ++j) v[j] = tile[(kc * 8 + j) * 65 + n];
      u32x4 w; w.x = cvt_pk_bf16(v[0], v[1]); w.y = cvt_pk_bf16(v[2], v[3]); w.z = cvt_pk_bf16(v[4], v[5]); w.w = cvt_pk_bf16(v[6], v[7]);
      *(u32x4*)(dst + (size_t)(n0 + n) * K + k0 + kc * 8) = w;
    }
    __syncthreads();
  }
  }
  rot = (rot + nt) % G;
}

DI void prep_adaln(const float* __restrict__ cvec, const float* __restrict__ ada_w, const float* __restrict__ ada_b, float* mod, LAS float* lbuf) {
  const int tid = otid();
  LAS float* cact = lbuf;
  LAS float* red = lbuf + 8 * 1024;
  for (int i = tid; i < 8 * 1024; i += 512) cact[i] = siluf_(cvec[i]);
  __syncthreads();
  const int col = tid & 31, kc = tid >> 5;
  for (int item = blockIdx.x; item < NLAYER * 288; item += gridDim.x) {
    const int l = item / 288, nc = item - l * 288;
    const int n = nc * 32 + col;
    float acc[8];
#pragma unroll
    for (int b = 0; b < 8; ++b) acc[b] = 0.f;
    const float* w = ada_w + ((size_t)l * D + kc * 64) * NMOD + n;
    for (int k0 = 0; k0 < 64; k0 += 32) {
      float wv[32];
#pragma unroll
      for (int k = 0; k < 32; ++k) wv[k] = w[(size_t)(k0 + k) * NMOD];
#pragma unroll
      for (int k = 0; k < 32; ++k)
#pragma unroll
        for (int b = 0; b < 8; ++b) acc[b] += cact[b * 1024 + kc * 64 + k0 + k] * wv[k];
    }
#pragma unroll
    for (int b = 0; b < 8; ++b) red[(kc * 8 + b) * 32 + col] = acc[b];
    __syncthreads();
    if (tid < 256) { const int b = tid >> 5; float s = ada_b[l * NMOD + n];
#pragma unroll
      for (int q = 0; q < 16; ++q) s += red[(q * 8 + b) * 32 + col];
      mod[(size_t)(l * NB + b) * NMOD + n] = s; }
    __syncthreads();
  }
}

DI void prep_misc(const int* __restrict__ positions, const float* __restrict__ cmp_pe, const float* __restrict__ cmp_w1, float* ropec, float* ropes, float* cbias, LAS float* scr) {
  const int tid = otid();
  const double inv_tab[16] = {1.0, 0.5623413251903491, 0.31622776601683794, 0.1778279410038923, 0.1, 0.05623413251903491, 0.03162277660168379, 0.01778279410038923,
                              0.01, 0.005623413251903491, 0.0031622776601683794, 0.0017782794100389228, 0.001, 0.0005623413251903491, 0.00031622776601683794, 0.00017782794100389227};
  for (int idx = blockIdx.x * 512 + tid; idx < T * 16; idx += gridDim.x * 512) {
    const int t = idx >> 4, i = idx & 15;
    double invd = 1.0;
#pragma unroll
    for (int j = 0; j < 16; ++j) if (i == j) invd = inv_tab[j];
    const float ang = (float)positions[t] * (float)invd;
    const double a = (double)ang;
    const double rev = a * 0.15915494309189535;
    const double fr = rev - __builtin_rint(rev);
    const float rr = (float)(fr * 6.283185307179586);
    ropec[idx] = __cosf(rr); ropes[idx] = __sinf(rr);
  }
  for (int item = blockIdx.x; item < 64; item += gridDim.x) {
    const int mk = item >> 4, chunk = item & 15, col = tid & 127, kq = tid >> 7;
    const float* pe = cmp_pe + (size_t)mk * 2048 + chunk * 128 + kq * 32; const float* w1 = cmp_w1 + ((size_t)mk * 2048 + chunk * 128 + kq * 32) * 128 + col;
    float s = 0.f;
#pragma unroll
    for (int k = 0; k < 32; ++k) s += pe[k] * w1[(size_t)k * 128];
    scr[tid] = s; __syncthreads();
    if (tid < 128) cbias[item * 128 + tid] = (scr[tid] + scr[tid + 128]) + (scr[tid + 256] + scr[tid + 384]);
    __syncthreads();
  }
}

template <int MODE> DI void norm_phase(const float* __restrict__ x, const float* __restrict__ g, const float* __restrict__ sh, const float* __restrict__ sc, bf16_t* outb, float* outf) {
  const int lane = otid() & 63, wv = otid() >> 6;
  const int G_ = (int)gridDim.x, c_ = (int)blockIdx.x; const bool xa_ = (G_ & 7) == 0;
  const int rbeg_ = xa_ ? (c_ & 7) * SEQ + (c_ >> 3) * 8 : c_ * 8, rend_ = xa_ ? (c_ & 7) * SEQ + SEQ : T, rstep_ = xa_ ? (G_ >> 3) * 8 : G_ * 8;
#pragma unroll 2
  for (int row = rbeg_ + wv; row < rend_; row += rstep_) {
    const int b = row >> 11;
    const float4* xr = (const float4*)(x + (size_t)row * D);
    float4 v[4]; float ss = 0.f;
#pragma unroll
    for (int i = 0; i < 4; ++i) { v[i] = xr[lane + 64 * i]; ss += v[i].x * v[i].x + v[i].y * v[i].y + v[i].z * v[i].z + v[i].w * v[i].w; }
    ss = wave_sum(ss);
    const float rstd = rsqrtf(ss * (1.f / D) + EPS);
#pragma unroll
    for (int i = 0; i < 4; ++i) {
      const int col = 4 * (lane + 64 * i);
      const float4 gg = *(const float4*)(g + col);
      if (MODE == 0) {
        const float4 s1 = *(const float4*)(sc + (size_t)b * NMOD + col), s0 = *(const float4*)(sh + (size_t)b * NMOD + col);
        const float h0 = v[i].x * rstd * gg.x * (1.f + s1.x) + s0.x, h1 = v[i].y * rstd * gg.y * (1.f + s1.y) + s0.y;
        const float h2 = v[i].z * rstd * gg.z * (1.f + s1.z) + s0.z, h3 = v[i].w * rstd * gg.w * (1.f + s1.w) + s0.w;
        u32x2 w; w.x = cvt_pk_bf16(h0, h1); w.y = cvt_pk_bf16(h2, h3);
        *(u32x2*)(outb + (size_t)row * D + col) = w;
      } else {
        float4 o; o.x = v[i].x * rstd * gg.x; o.y = v[i].y * rstd * gg.y; o.z = v[i].z * rstd * gg.z; o.w = v[i].w * rstd * gg.w;
        *(float4*)(outf + (size_t)row * D + col) = o;
      }
    }
  }
}
using pg8::Unit;
typedef f32x4 AccT[2][2][4][2];

struct EpiSwiglu {
  static constexpr bool PERM = true, AFTER_DRAIN = false;
  bf16_t* U;
  DI void operator()(const AccT& acc, const Unit& u, int wr, int wc, int fr, int fq) const {
    const int row0 = u.pm * 256 + wr * 64 + fr, col0 = u.pn * 128 + wc * 32 + 8 * fq;
#pragma unroll
    for (int ai = 0; ai < 2; ++ai)
#pragma unroll
      for (int m = 0; m < 4; ++m) {
        const f32x4 a0 = acc[ai][0][m][0], a1 = acc[ai][0][m][1], b0 = acc[ai][1][m][0], b1 = acc[ai][1][m][1];
        float h[8];
#pragma unroll
        for (int e = 0; e < 4; ++e) { h[e] = siluf_(a0[e]) * b0[e]; h[4 + e] = siluf_(a1[e]) * b1[e]; }
        u32x4 w; w.x = cvt_pk_bf16(h[0], h[1]); w.y = cvt_pk_bf16(h[2], h[3]); w.z = cvt_pk_bf16(h[4], h[5]); w.w = cvt_pk_bf16(h[6], h[7]);
        __builtin_nontemporal_store(w, (u32x4*)(U + (size_t)(row0 + ai * 128 + m * 16) * DFF + col0));
        asm volatile("" ::: "memory");
      }
  }
};

struct EpiResid {
  static constexpr bool PERM = true, AFTER_DRAIN = false;
  const float* xin; float* xout; const float* gate; float coef;
  DI void operator()(const AccT& acc, const Unit& u, int wr, int wc, int fr, int fq) const {
    const int row0 = u.pm * 256 + wr * 64 + fr, col0 = u.pn * 256 + wc * 32 + 8 * fq;
    const int b = (u.pm * 256) >> 11;
    f32x4 gv[2][2];
#pragma unroll
    for (int bj = 0; bj < 2; ++bj)
#pragma unroll
      for (int n = 0; n < 2; ++n) gv[bj][n] = *(const f32x4*)(gate + (size_t)b * NMOD + col0 + bj * 128 + 4 * n) * coef;
#pragma unroll
    for (int ai = 0; ai < 2; ++ai)
#pragma unroll
      for (int m = 0; m < 4; ++m) {
        const size_t ro = (size_t)(row0 + ai * 128 + m * 16) * D;
#pragma unroll
        for (int bj = 0; bj < 2; ++bj)
#pragma unroll
          for (int n = 0; n < 2; ++n) {
            const int c = col0 + bj * 128 + 4 * n;
            const f32x4 xv = *(const f32x4*)(xin + ro + c);
            *(f32x4*)(xout + ro + c) = xv + gv[bj][n] * acc[ai][bj][m][n];
          }
        asm volatile("" ::: "memory");
      }
  }
};

struct EpiPlain {
  static constexpr bool PERM = true, AFTER_DRAIN = false;
  bf16_t* O; int ldc;
  DI void operator()(const AccT& acc, const Unit& u, int wr, int wc, int fr, int fq) const {
    const int row0 = u.pm * 256 + wr * 64 + fr, col0 = u.pn * 256 + wc * 32 + 8 * fq;
#pragma unroll
    for (int ai = 0; ai < 2; ++ai)
#pragma unroll
      for (int m = 0; m < 4; ++m)
#pragma unroll
        for (int bj = 0; bj < 2; ++bj) {
          const f32x4 v0 = acc[ai][bj][m][0], v1 = acc[ai][bj][m][1];
          u32x4 w; w.x = cvt_pk_bf16(v0[0], v0[1]); w.y = cvt_pk_bf16(v0[2], v0[3]); w.z = cvt_pk_bf16(v1[0], v1[1]); w.w = cvt_pk_bf16(v1[2], v1[3]);
          *(u32x4*)(O + (size_t)(row0 + ai * 128 + m * 16) * ldc + col0 + bj * 128) = w;
          asm volatile("" ::: "memory");
        }
  }
};

struct EpiQRope {
  static constexpr bool PERM = true, AFTER_DRAIN = false;
  bf16_t* Q; const float* rc; const float* rs; float qscale;
  DI void operator()(const AccT& acc, const Unit& u, int wr, int wc, int fr, int fq) const {
    const int row0 = u.pm * 256 + wr * 64 + fr;
#pragma unroll
    for (int bj = 0; bj < 2; ++bj) {
      const int c32 = u.pn * 256 + bj * 128 + wc * 32;
      const bool rope = (c32 % 96) == 64;
      const int col0 = c32 + 8 * fq;
#pragma unroll
      for (int ai = 0; ai < 2; ++ai)
#pragma unroll
        for (int m = 0; m < 4; ++m) {
          const int row = row0 + ai * 128 + m * 16;
          f32x4 v0 = acc[ai][bj][m][0], v1 = acc[ai][bj][m][1];
          if (rope) {
            const f32x4 cs = *(const f32x4*)(rc + (size_t)row * 16 + 4 * fq), sn = *(const f32x4*)(rs + (size_t)row * 16 + 4 * fq);
            f32x4 r0, r1;
            r0[0] = v0[0] * cs[0] - v0[1] * sn[0]; r0[1] = v0[0] * sn[0] + v0[1] * cs[0];
            r0[2] = v0[2] * cs[1] - v0[3] * sn[1]; r0[3] = v0[2] * sn[1] + v0[3] * cs[1];
            r1[0] = v1[0] * cs[2] - v1[1] * sn[2]; r1[1] = v1[0] * sn[2] + v1[1] * cs[2];
            r1[2] = v1[2] * cs[3] - v1[3] * sn[3]; r1[3] = v1[2] * sn[3] + v1[3] * cs[3];
            v0 = r0; v1 = r1;
          }
          v0 = v0 * qscale; v1 = v1 * qscale;
          u32x4 w; w.x = cvt_pk_bf16(v0[0], v0[1]); w.y = cvt_pk_bf16(v0[2], v0[3]); w.z = cvt_pk_bf16(v1[0], v1[1]); w.w = cvt_pk_bf16(v1[2], v1[3]);
          *(u32x4*)(Q + (size_t)row * 768 + col0) = w;
          asm volatile("" ::: "memory");
        }
    }
  }
};

DI void store_vt8(bf16_t* vt_base  , const f32x4& v0, const f32x4& v1) {
  const unsigned w0 = cvt_pk_bf16(v0[0], v0[1]), w1 = cvt_pk_bf16(v0[2], v0[3]), w2 = cvt_pk_bf16(v1[0], v1[1]), w3 = cvt_pk_bf16(v1[2], v1[3]);
  vt_base[0 * SEQ] = (bf16_t)(w0 & 0xffffu); vt_base[1 * SEQ] = (bf16_t)(w0 >> 16);
  vt_base[2 * SEQ] = (bf16_t)(w1 & 0xffffu); vt_base[3 * SEQ] = (bf16_t)(w1 >> 16);
  vt_base[4 * SEQ] = (bf16_t)(w2 & 0xffffu); vt_base[5 * SEQ] = (bf16_t)(w2 >> 16);
  vt_base[6 * SEQ] = (bf16_t)(w3 & 0xffffu); vt_base[7 * SEQ] = (bf16_t)(w3 >> 16);
}

struct EpiMlaKV {
  static constexpr bool PERM = true, AFTER_DRAIN = false;
  bf16_t* Kb; bf16_t* Vt;
  DI void operator()(const AccT& acc, const Unit& u, int wr, int wc, int fr, int fq) const {
    const int row0 = u.pm * 256 + wr * 64 + fr;
    const int b = (u.pm * 256) >> 11;
#pragma unroll
    for (int bj = 0; bj < 2; ++bj) {
      const int h = u.pn * 2 + bj, j0 = wc * 32 + 8 * fq;
#pragma unroll
      for (int ai = 0; ai < 2; ++ai)
#pragma unroll
        for (int m = 0; m < 4; ++m) {
          const int row = row0 + ai * 128 + m * 16, s = row & (SEQ - 1);
          const f32x4 v0 = acc[ai][bj][m][0], v1 = acc[ai][bj][m][1];
          if (wc < 2) {
            u32x4 w; w.x = cvt_pk_bf16(v0[0], v0[1]); w.y = cvt_pk_bf16(v0[2], v0[3]); w.z = cvt_pk_bf16(v1[0], v1[1]); w.w = cvt_pk_bf16(v1[2], v1[3]);
            *(u32x4*)(Kb + (size_t)row * 768 + h * 96 + j0) = w;
          } else {
            store_vt8(Vt + ((size_t)(b * 8 + h) * 64 + (j0 - 64)) * SEQ + s, v0, v1);
          }
          asm volatile("" ::: "memory");
        }
    }
  }
};

struct EpiNsaIn {
  static constexpr bool PERM = true, AFTER_DRAIN = false;
  bf16_t* Q; bf16_t* KVC; bf16_t* KS; bf16_t* VTS; bf16_t* KW; bf16_t* VTW; float* GT; const float* gate_b; float qscale;
  DI void operator()(const AccT& acc, const Unit& u, int wr, int wc, int fr, int fq) const {
    const int row0 = u.pm * 256 + wr * 64 + fr;
    const int b = (u.pm * 256) >> 11;
    const int pn = u.pn;
#pragma unroll
    for (int bj = 0; bj < 2; ++bj) {
      const int cl = bj * 128 + wc * 32 + 8 * fq;
      const int g = wc >> 1, d0 = (wc & 1) * 32 + 8 * fq;
#pragma unroll
      for (int ai = 0; ai < 2; ++ai)
#pragma unroll
        for (int m = 0; m < 4; ++m) {
          const int row = row0 + ai * 128 + m * 16, s = row & (SEQ - 1);
          f32x4 v0 = acc[ai][bj][m][0], v1 = acc[ai][bj][m][1];
          if (pn < 4) {
            v0 = v0 * qscale; v1 = v1 * qscale;
            u32x4 w; w.x = cvt_pk_bf16(v0[0], v0[1]); w.y = cvt_pk_bf16(v0[2], v0[3]); w.z = cvt_pk_bf16(v1[0], v1[1]); w.w = cvt_pk_bf16(v1[2], v1[3]);
            *(u32x4*)(Q + (size_t)row * 1024 + pn * 256 + cl) = w;
          } else if (pn == 4) {
            u32x4 w; w.x = cvt_pk_bf16(v0[0], v0[1]); w.y = cvt_pk_bf16(v0[2], v0[3]); w.z = cvt_pk_bf16(v1[0], v1[1]); w.w = cvt_pk_bf16(v1[2], v1[3]);
            *(u32x4*)(KVC + ((size_t)((bj * 8 + b) * 2 + g) * SEQ + s) * 64 + d0) = w;
          } else if (pn < 7) {
            bf16_t* Kd = pn == 5 ? KS : KW; bf16_t* Vd = pn == 5 ? VTS : VTW;
            if (bj == 0) {
              u32x4 w; w.x = cvt_pk_bf16(v0[0], v0[1]); w.y = cvt_pk_bf16(v0[2], v0[3]); w.z = cvt_pk_bf16(v1[0], v1[1]); w.w = cvt_pk_bf16(v1[2], v1[3]);
              *(u32x4*)(Kd + ((size_t)(b * 2 + g) * SEQ + s) * 64 + d0) = w;
            } else {
              store_vt8(Vd + ((size_t)(b * 2 + g) * 64 + d0) * SEQ + s, v0, v1);
            }
          } else {
            if (cl < 48) {
              const f32x4 g0 = *(const f32x4*)(gate_b + cl), g1 = *(const f32x4*)(gate_b + cl + 4);
              f32x4 o0, o1;
#pragma unroll
              for (int e = 0; e < 4; ++e) { o0[e] = sigmoidf_(v0[e] + g0[e]); o1[e] = sigmoidf_(v1[e] + g1[e]); }
              *(f32x4*)(GT + (size_t)row * 48 + cl) = o0; *(f32x4*)(GT + (size_t)row * 48 + cl + 4) = o1;
            }
          }
          asm volatile("" ::: "memory");
        }
    }
  }
};

struct EpiCmp {
  static constexpr bool PERM = true, AFTER_DRAIN = false;
  float* CH;
  DI void operator()(const AccT& acc, const Unit& u, int wr, int wc, int fr, int fq) const {
    const int row0 = u.pm * 256 + wr * 64 + fr, col0 = wc * 32 + 8 * fq;
#pragma unroll
    for (int ai = 0; ai < 2; ++ai)
#pragma unroll
      for (int m = 0; m < 4; ++m) {
        float* dst = CH + (size_t)(row0 + ai * 128 + m * 16) * 128 + col0;
        *(f32x4*)dst = acc[ai][0][m][0]; *(f32x4*)(dst + 4) = acc[ai][0][m][1];
        asm volatile("" ::: "memory");
      }
  }
};
DI void mla_prep_phase(const bf16_t* __restrict__ Z, const float* __restrict__ conv_w, const float* __restrict__ qn, const float* __restrict__ kvn,
                       const float* __restrict__ rc, const float* __restrict__ rs, bf16_t* YB, bf16_t* CQ, bf16_t* CKV, bf16_t* Kb) {
  const int lane = otid() & 63, wv = otid() >> 6;
  const int G_ = (int)gridDim.x, c_ = (int)blockIdx.x; const bool xa_ = (G_ & 7) == 0;
  const int tbeg_ = xa_ ? (c_ & 7) * SEQ + (c_ >> 3) * 8 : c_ * 8, tend_ = xa_ ? (c_ & 7) * SEQ + SEQ : T, tstep_ = xa_ ? (G_ >> 3) * 8 : G_ * 8;
#pragma unroll 2
  for (int t = tbeg_ + wv; t < tend_; t += tstep_) {
    const int s = t & (SEQ - 1);
    const bf16_t* zr = Z + (size_t)t * 2048;
    {
      const int c0 = lane * 8;
      float accv[8];
#pragma unroll
      for (int e = 0; e < 8; ++e) accv[e] = 0.f;
#pragma unroll
      for (int j = 0; j < 3; ++j) {
        const int dt = 2 - j;
        if (s - dt >= 0) {
          const bf16_t* zz = zr - (size_t)dt * 2048;
          const u32x4 uu = *(const u32x4*)(zz + c0), gc = *(const u32x4*)(zz + 512 + c0);
          const float4 w0 = *(const float4*)(conv_w + j * 512 + c0), w1 = *(const float4*)(conv_w + j * 512 + c0 + 4);
          accv[0] += w0.x * bflo(uu.x) * bflo(gc.x); accv[1] += w0.y * bfhi(uu.x) * bfhi(gc.x);
          accv[2] += w0.z * bflo(uu.y) * bflo(gc.y); accv[3] += w0.w * bfhi(uu.y) * bfhi(gc.y);
          accv[4] += w1.x * bflo(uu.z) * bflo(gc.z); accv[5] += w1.y * bfhi(uu.z) * bfhi(gc.z);
          accv[6] += w1.z * bflo(uu.w) * bflo(gc.w); accv[7] += w1.w * bfhi(uu.w) * bfhi(gc.w);
        }
      }
      const u32x4 gb = *(const u32x4*)(zr + 1024 + c0);
      u32x4 w;
      w.x = cvt_pk_bf16(accv[0] * bflo(gb.x), accv[1] * bfhi(gb.x)); w.y = cvt_pk_bf16(accv[2] * bflo(gb.y), accv[3] * bfhi(gb.y));
      w.z = cvt_pk_bf16(accv[4] * bflo(gb.z), accv[5] * bfhi(gb.z)); w.w = cvt_pk_bf16(accv[6] * bflo(gb.w), accv[7] * bfhi(gb.w));
      *(u32x4*)(YB + (size_t)t * 1024 + c0) = w;
    }
    {
      const u32x2 q = *(const u32x2*)(zr + 1536 + lane * 4);
      const float a0 = bflo(q.x), a1 = bfhi(q.x), a2 = bflo(q.y), a3 = bfhi(q.y);
      const float ss = wave_sum(a0 * a0 + a1 * a1 + a2 * a2 + a3 * a3);
      const float rstd = rsqrtf(ss * (1.f / 256.f) + EPS);
      const float4 gg = *(const float4*)(qn + lane * 4);
      u32x2 w; w.x = cvt_pk_bf16(a0 * rstd * gg.x, a1 * rstd * gg.y); w.y = cvt_pk_bf16(a2 * rstd * gg.z, a3 * rstd * gg.w);
      *(u32x2*)(CQ + (size_t)t * 256 + lane * 4) = w;
    }
    {
      const unsigned q = *(const unsigned*)(zr + 1792 + lane * 2);
      const float a0 = bflo(q), a1 = bfhi(q);
      const float ss = wave_sum(a0 * a0 + a1 * a1);
      const float rstd = rsqrtf(ss * (1.f / 128.f) + EPS);
      const float2 gg = *(const float2*)(kvn + lane * 2);
      *(unsigned*)(CKV + (size_t)t * 128 + lane * 2) = cvt_pk_bf16(a0 * rstd * gg.x, a1 * rstd * gg.y);
    }
    if (lane < 16) {
      const float t1 = bf2f(zr[1920 + lane]), t2 = bf2f(zr[1936 + lane]);
      const float cs = rc[(size_t)t * 16 + lane], sn = rs[(size_t)t * 16 + lane];
      const unsigned w = cvt_pk_bf16(t1 * cs - t2 * sn, t1 * sn + t2 * cs);
#pragma unroll
      for (int h = 0; h < 8; ++h) *(unsigned*)(Kb + (size_t)t * 768 + h * 96 + 64 + 2 * lane) = w;
    }
  }
}

typedef float f32x2_t_ __attribute__((ext_vector_type(2)));
typedef __bf16 bf16x2_t_ __attribute__((ext_vector_type(2)));
DI unsigned cvt_pk_v(float lo, float hi) { f32x2_t_ v = {lo, hi}; bf16x2_t_ b = __builtin_convertvector(v, bf16x2_t_); return __builtin_bit_cast(unsigned, b); }
DI float max3f_(float a, float b, float c) { float r; asm("v_max3_f32 %0, %1, %2, %3" : "=v"(r) : "v"(a), "v"(b), "v"(c)); return r; }
DI float fsub_(float a, float b) { float r; asm("v_sub_f32_e32 %0, %1, %2" : "=v"(r) : "v"(a), "v"(b)); return r; }
DI float fadd_(float a, float b) { float r; asm("s_nop 0\n\tv_add_f32_e32 %0, %1, %2" : "=v"(r) : "v"(a), "v"(b)); return r; }
DI float fmul_(float a, float b) { float r; asm("s_nop 0\n\tv_mul_f32_e32 %0, %1, %2" : "=v"(r) : "v"(a), "v"(b)); return r; }
#ifndef ATT_TWO_TILES
#define ATT_TWO_TILES(dqk, qt) ((qt) == 1 || (dqk) == 96)
#endif
constexpr int VSTR = 72;
template <int KS, int KSTR, int QT, int MM, bool QLDS>
DI void attn_step(f32x4 (&o)[QT][4], float (&m)[QT], float (&l)[QT], const bf16x8 (&qf)[QT][KS], const LAS bf16_t* Ql, const LAS bf16_t* Kl, const LAS bf16_t* Vl,
                  int lane, int kbase, const int (&lo)[QT], const int (&hi)[QT]) {
  const int r = lane & 15, g = lane >> 4;
  f32x4 s[QT][4];
#pragma unroll
  for (int kt = 0; kt < 4; ++kt) {
#pragma unroll
    for (int qt = 0; qt < QT; ++qt) s[qt][kt] = (f32x4){0.f, 0.f, 0.f, 0.f};
#pragma unroll
    for (int ks = 0; ks < KS; ++ks) {
      const bf16x8 kf = *(const LAS bf16x8*)(Kl + (kt * 16 + r) * KSTR + ks * 32 + g * 8);
#pragma unroll
      for (int qt = 0; qt < QT; ++qt) {
        const bf16x8 qv = QLDS ? *(const LAS bf16x8*)(Ql + ((qt * KS + ks) * 64 + lane) * 8) : qf[qt][ks];
        s[qt][kt] = MFMA16(kf, qv, s[qt][kt]);
      }
    }
  }
#pragma unroll
  for (int qt = 0; qt < QT; ++qt) {
    if (qt == 0) asm volatile("s_nop 7\n\ts_nop 7" : "+v"(s[qt][0]), "+v"(s[qt][1]), "+v"(s[qt][2]), "+v"(s[qt][3]));
    else asm volatile("" : "+v"(s[qt][0]), "+v"(s[qt][1]), "+v"(s[qt][2]), "+v"(s[qt][3]));
  }
#pragma unroll
  for (int qt = 0; qt < QT; ++qt) {
    float mx = -1e30f;
    if (MM == 1) {
#pragma unroll
      for (int kt = 0; kt < 4; ++kt)
#pragma unroll
        for (int i = 0; i < 4; ++i) {
          const int key = kbase + kt * 16 + g * 4 + i;
          const bool valid = (key >= lo[qt]) && (key <= hi[qt]);
          const float sv = valid ? s[qt][kt][i] : -1e30f;
          s[qt][kt][i] = sv; mx = fmaxf(mx, sv);
        }
    } else {
#pragma unroll
      for (int kt = 0; kt < 4; ++kt) { mx = max3f_(mx, s[qt][kt][0], s[qt][kt][1]); mx = max3f_(mx, s[qt][kt][2], s[qt][kt][3]); }
      if (MM == 2) mx = (lo[qt] == 0) ? mx : -1e30f;
    }
    mx = max3f_(mx, __shfl_xor(mx, 16), -1e30f); mx = max3f_(mx, __shfl_xor(mx, 32), -1e30f);
    const float mn = max3f_(m[qt], mx, -1e30f);
    const float alpha = fast_exp2(m[qt] - mn);
    float rsum = 0.f;
    if (MM == 1) {
#pragma unroll
      for (int kt = 0; kt < 4; ++kt)
#pragma unroll
        for (int i = 0; i < 4; ++i) {
          const float sv = s[qt][kt][i];
          const float pv = (sv > -1e29f) ? fast_exp2(sv - mn) : 0.f;
          s[qt][kt][i] = pv; rsum += pv;
        }
    } else {
      const float mne = (MM == 2) ? ((lo[qt] == 0) ? mn : 1e30f) : mn;
      f32x4 ps = (f32x4){0.f, 0.f, 0.f, 0.f};
#pragma unroll
      for (int kt = 0; kt < 4; ++kt) {
        const f32x4 dv = s[qt][kt] - mne;
        f32x4 pv; pv[0] = fast_exp2(dv[0]); pv[1] = fast_exp2(dv[1]); pv[2] = fast_exp2(dv[2]); pv[3] = fast_exp2(dv[3]);
        s[qt][kt] = pv; ps = ps + pv;
      }
      rsum = (ps[0] + ps[1]) + (ps[2] + ps[3]);
    }
    rsum += __shfl_xor(rsum, 16); rsum += __shfl_xor(rsum, 32);
    l[qt] = l[qt] * alpha + rsum; m[qt] = mn;
    if (!__all(alpha == 1.0f)) {
#pragma unroll
      for (int dt = 0; dt < 4; ++dt) o[qt][dt] = o[qt][dt] * alpha;
    }
  }
#pragma unroll
  for (int k2 = 0; k2 < 2; ++k2) {
    bf16x8 pb[QT];
#pragma unroll
    for (int qt = 0; qt < QT; ++qt) {
      u32x4 w; w.x = cvt_pk_v(s[qt][2 * k2][0], s[qt][2 * k2][1]); w.y = cvt_pk_v(s[qt][2 * k2][2], s[qt][2 * k2][3]);
      w.z = cvt_pk_v(s[qt][2 * k2 + 1][0], s[qt][2 * k2 + 1][1]); w.w = cvt_pk_v(s[qt][2 * k2 + 1][2], s[qt][2 * k2 + 1][3]);
      pb[qt] = __builtin_bit_cast(bf16x8, w);
    }
#pragma unroll
    for (int dt = 0; dt < 4; ++dt) {
      const LAS bf16_t* vp = Vl + (dt * 16 + r) * VSTR + k2 * 32 + 4 * g;
      const u32x2 lo2 = *(const LAS u32x2*)vp, hi2 = *(const LAS u32x2*)(vp + 16);
      u32x4 vv; vv.x = lo2.x; vv.y = lo2.y; vv.z = hi2.x; vv.w = hi2.y;
      const bf16x8 vf = __builtin_bit_cast(bf16x8, vv);
#pragma unroll
      for (int qt = 0; qt < QT; ++qt) o[qt][dt] = MFMA16(vf, pb[qt], o[qt][dt]);
    }
  }
}

template <int DQK, int QT, int MODE, bool QLDS>
DI void attn_tile(f32x4 (&o)[QT][4], float (&m)[QT], float (&l)[QT], const bf16x8 (&qf)[QT][DQK / 32], const LAS bf16_t* Ql, const LAS bf16_t* Kl, const LAS bf16_t* Vl,
                  int j, const int (&tq)[QT], const unsigned (&sel)[QT], int twave_min, int twave_max) {
  constexpr int KSTR = DQK + 8, KS = DQK / 32;
  const int lane = otid() & 63;
  const int kbase = j * 64;
  if (MODE == 1) { bool anysel = false;
#pragma unroll
    for (int qt = 0; qt < QT; ++qt) anysel = anysel || ((sel[qt] >> j) & 1u);
    if (!__any(anysel)) return; }
  bool act;
  if (MODE == 2) act = (kbase + 63 >= twave_min - 511) && (kbase <= twave_max); else act = (kbase <= twave_max);
  if (act) {
    int lo[QT], hi[QT];
    bool full = true;
#pragma unroll
    for (int qt = 0; qt < QT; ++qt) {
      hi[qt] = tq[qt];
      if (MODE == 0) lo[qt] = 0; else if (MODE == 1) lo[qt] = ((sel[qt] >> j) & 1u) ? 0 : 0x7fffffff; else lo[qt] = tq[qt] - 511;
      full = full && (lo[qt] <= kbase) && (hi[qt] >= kbase + 63);
    }
    if (__all(full)) attn_step<KS, KSTR, QT, 0, QLDS>(o, m, l, qf, Ql, Kl, Vl, lane, kbase, lo, hi);
    else if (MODE == 1 && kbase + 63 <= twave_min) attn_step<KS, KSTR, QT, 2, QLDS>(o, m, l, qf, Ql, Kl, Vl, lane, kbase, lo, hi);
    else attn_step<KS, KSTR, QT, 1, QLDS>(o, m, l, qf, Ql, Kl, Vl, lane, kbase, lo, hi);
  }
}

template <int DQK, int QT, int MODE, bool QLDS>
DI void attn_loop(f32x4 (&o)[QT][4], float (&m)[QT], float (&l)[QT], const bf16x8 (&qf)[QT][DQK / 32], const LAS bf16_t* Ql, unsigned rem,
                  const bf16_t* __restrict__ Kg, int kstride, const bf16_t* __restrict__ Vtg, int vstride,
                  LAS bf16_t* Kl0, LAS bf16_t* Vl0, const int (&tq)[QT], const unsigned (&sel)[QT], int twave_min, int twave_max) {
  constexpr int KSTR = DQK + 8, CPR = DQK / 8, NKC = (64 * CPR + 511) / 512;
  constexpr int KBUF = 64 * KSTR, VBUF = 64 * VSTR;
  const int tid = otid();
  constexpr bool TWO = ATT_TWO_TILES(DQK, QT); constexpr int SL = TWO ? 2 : 1;
  u32x4 krA[NKC], vrA, krB[TWO ? NKC : 1], vrB;
#define ATT_GLOAD(jj, KR, VR) do { _Pragma("unroll") for (int c_ = 0; c_ < NKC; ++c_) { const int ch_ = tid + c_ * 512; if (ch_ < 64 * CPR) { const int row_ = ch_ / CPR, cc_ = ch_ - row_ * CPR; \
      KR[c_] = *(const u32x4*)(Kg + (size_t)((jj) * 64 + row_) * kstride + cc_ * 8); } } \
    { const int d_ = tid >> 3, cc_ = tid & 7; VR = *(const u32x4*)(Vtg + (size_t)d_ * vstride + (jj) * 64 + cc_ * 8); } } while (0)
#define ATT_LSTORE(slot, KR, VR) do { _Pragma("unroll") for (int c_ = 0; c_ < NKC; ++c_) { const int ch_ = tid + c_ * 512; if (ch_ < 64 * CPR) { const int row_ = ch_ / CPR, cc_ = ch_ - row_ * CPR; \
      *(LAS u32x4*)(Kl0 + (slot) * KBUF + row_ * KSTR + cc_ * 8) = KR[c_]; } } \
    { const int d_ = tid >> 3, cc_ = tid & 7; *(LAS u32x4*)(Vl0 + (slot) * VBUF + d_ * VSTR + cc_ * 8) = VR; } } while (0)
  if (rem == 0u) return;
  int j0 = __builtin_ctz(rem); rem &= rem - 1u;
  int j1 = -1; if (TWO && rem) { j1 = __builtin_ctz(rem); rem &= rem - 1u; }
  ATT_GLOAD(j0, krA, vrA); if (TWO && j1 >= 0) ATT_GLOAD(j1, krB, vrB);
  ATT_LSTORE(0, krA, vrA); if (TWO && j1 >= 0) ATT_LSTORE(1, krB, vrB);
  __syncthreads();
  int buf = 0;
  for (;;) {
    int n0 = -1, n1 = -1;
    if (rem) { n0 = __builtin_ctz(rem); rem &= rem - 1u; ATT_GLOAD(n0, krA, vrA); }
    if (TWO && rem) { n1 = __builtin_ctz(rem); rem &= rem - 1u; ATT_GLOAD(n1, krB, vrB); }
    attn_tile<DQK, QT, MODE, QLDS>(o, m, l, qf, Ql, Kl0 + (buf * SL) * KBUF, Vl0 + (buf * SL) * VBUF, j0, tq, sel, twave_min, twave_max);
    if (TWO && j1 >= 0) attn_tile<DQK, QT, MODE, QLDS>(o, m, l, qf, Ql, Kl0 + (buf * SL + 1) * KBUF, Vl0 + (buf * SL + 1) * VBUF, j1, tq, sel, twave_min, twave_max);
    if (n0 >= 0) ATT_LSTORE((buf ^ 1) * SL, krA, vrA);
    if (TWO && n1 >= 0) ATT_LSTORE((buf ^ 1) * SL + 1, krB, vrB);
    __syncthreads();
    if (n0 < 0) break;
    j0 = n0; j1 = n1; buf ^= 1;
  }
#undef ATT_GLOAD
#undef ATT_LSTORE
}


template <int MODE>
DI void attn_loop_pair(f32x4 (&oA)[1][4], float (&mA)[1], float (&lA)[1], const bf16x8 (&qA)[1][2], const int (&tqA)[1], const unsigned (&selA)[1], int tminA, int tmaxA,
                       f32x4 (&oB)[1][4], float (&mB)[1], float (&lB)[1], const bf16x8 (&qB)[1][2], const int (&tqB)[1], const unsigned (&selB)[1], int tminB, int tmaxB,
                       unsigned rem, const bf16_t* __restrict__ Kg, int kstride, const bf16_t* __restrict__ Vtg, int vstride, LAS bf16_t* Kl0, LAS bf16_t* Vl0) {
  constexpr int KSTR = 72, KBUF = 64 * KSTR, VBUF = 64 * VSTR;
  const int tid = otid();
  const int krow = tid >> 3, kcc = tid & 7;
  u32x4 kA, vA, kB, vB;
#define PR_GLOAD(jj, KR, VR) do { KR = *(const u32x4*)(Kg + (size_t)((jj) * 64 + krow) * kstride + kcc * 8); VR = *(const u32x4*)(Vtg + (size_t)krow * vstride + (jj) * 64 + kcc * 8); } while (0)
#define PR_LSTORE(slot, KR, VR) do { *(LAS u32x4*)(Kl0 + (slot) * KBUF + krow * KSTR + kcc * 8) = KR; *(LAS u32x4*)(Vl0 + (slot) * VBUF + krow * VSTR + kcc * 8) = VR; } while (0)
#define PR_TILE(slot, jj) do { \
    attn_tile<64, 1, MODE, false>(oA, mA, lA, qA, (const LAS bf16_t*)nullptr, Kl0 + (slot) * KBUF, Vl0 + (slot) * VBUF, (jj), tqA, selA, tminA, tmaxA); \
    attn_tile<64, 1, MODE, false>(oB, mB, lB, qB, (const LAS bf16_t*)nullptr, Kl0 + (slot) * KBUF, Vl0 + (slot) * VBUF, (jj), tqB, selB, tminB, tmaxB); } while (0)
  if (rem == 0u) return;
  int j0 = __builtin_ctz(rem); rem &= rem - 1u;
  int j1 = -1; if (rem) { j1 = __builtin_ctz(rem); rem &= rem - 1u; }
  PR_GLOAD(j0, kA, vA); if (j1 >= 0) PR_GLOAD(j1, kB, vB);
  PR_LSTORE(0, kA, vA); if (j1 >= 0) PR_LSTORE(1, kB, vB);
  __syncthreads();
  int buf = 0;
  for (;;) {
    int n0 = -1, n1 = -1;
    if (rem) { n0 = __builtin_ctz(rem); rem &= rem - 1u; PR_GLOAD(n0, kA, vA); }
    if (rem) { n1 = __builtin_ctz(rem); rem &= rem - 1u; PR_GLOAD(n1, kB, vB); }
    PR_TILE(buf * 2, j0);
    if (j1 >= 0) PR_TILE(buf * 2 + 1, j1);
    if (n0 >= 0) PR_LSTORE((buf ^ 1) * 2, kA, vA);
    if (n1 >= 0) PR_LSTORE((buf ^ 1) * 2 + 1, kB, vB);
    __syncthreads();
    if (n0 < 0) break;
    j0 = n0; j1 = n1; buf ^= 1;
  }
#undef PR_GLOAD
#undef PR_LSTORE
#undef PR_TILE
}

DI void mla_attn_phase(const bf16_t* __restrict__ Qb, const bf16_t* __restrict__ Kb, const bf16_t* __restrict__ Vt, bf16_t* YB, LAS unsigned char* lds) {
  constexpr int QT = 2, DQK = 96, KS = 3;
  LAS bf16_t* Kl = (LAS bf16_t*)lds; LAS bf16_t* Vl = (LAS bf16_t*)(lds + 4 * 64 * (DQK + 8) * 2);
  const int tid = otid(), lane = tid & 63, wv = __builtin_amdgcn_readfirstlane(tid >> 6), G = gridDim.x, c = blockIdx.x;
  const bool xl = (G & 7) == 0;
  const int nsl = xl ? (G >> 3) : G, xcd = c & 7, slot = xl ? (c >> 3) : c, nun = xl ? 64 : 512;
  for (int rnd = 0; rnd * nsl < nun; ++rnd) {
    const int v = (rnd & 1) ? (rnd + 1) * nsl - 1 - slot : rnd * nsl + slot;
    if (v >= nun) continue;
    const int qb = 7 - (xl ? (v >> 3) : (v >> 6)), bh = xl ? (xcd * 8 + (v & 7)) : (v & 63), b = bh >> 3, h = bh & 7;
    const int q0 = qb * 256 + wv * 32;
    bf16x8 qf[QT][KS];
#pragma unroll
    for (int qt = 0; qt < QT; ++qt)
#pragma unroll
      for (int ks = 0; ks < KS; ++ks)
        qf[qt][ks] = *(const bf16x8*)(Qb + (size_t)(b * SEQ + q0 + qt * 16 + (lane & 15)) * 768 + h * 96 + ks * 32 + (lane >> 4) * 8);
    f32x4 o[QT][4]; float m[QT], l[QT]; int tq[QT]; unsigned sel[QT];
#pragma unroll
    for (int qt = 0; qt < QT; ++qt) { m[qt] = -1e30f; l[qt] = 0.f; tq[qt] = q0 + qt * 16 + (lane & 15); sel[qt] = 0u;
#pragma unroll
      for (int dt = 0; dt < 4; ++dt) o[qt][dt] = (f32x4){0.f, 0.f, 0.f, 0.f}; }
    const int jhi = (qb * 256 + 255) >> 6;
    const unsigned rem = (2u << jhi) - 1u;
    attn_loop<DQK, QT, 0, false>(o, m, l, qf, (const LAS bf16_t*)nullptr, rem, Kb + (size_t)b * SEQ * 768 + h * 96, 768, Vt + (size_t)(b * 8 + h) * 64 * SEQ, SEQ, Kl, Vl, tq, sel, q0, q0 + 31);
#pragma unroll
    for (int qt = 0; qt < QT; ++qt) {
      const float inv = 1.f / fmaxf(l[qt], 1e-20f);
      bf16_t* dst = YB + (size_t)(b * SEQ + tq[qt]) * 1024 + 512 + h * 64 + (lane >> 4) * 4;
#pragma unroll
      for (int dt = 0; dt < 4; ++dt) { const f32x4 v = o[qt][dt] * inv; u32x2 w; w.x = cvt_pk_bf16(v[0], v[1]); w.y = cvt_pk_bf16(v[2], v[3]); *(u32x2*)(dst + dt * 16) = w; }
    }
  }
}
DI void nsa_cmp2_phase(const float* __restrict__ CH  , const float* __restrict__ cbias  , const float* __restrict__ w2  , bf16_t* KC, bf16_t* VTC, LAS float* wl) {
  const int lane = otid() & 63, wv = otid() >> 6;
  for (int i = otid(); i < 2 * 128 * 64; i += 512) wl[i] = w2[i];
  __syncthreads();
  for (int item = blockIdx.x * 8 + wv; item < 2 * 2048; item += gridDim.x * 8) {
    const int kind = item >> 11, row = item & 2047, bg = row >> 7, n = row & 127;
    const float* ch = CH + ((size_t)kind * 8 * 2048 + row) * 128;
    const LAS float* w = wl + kind * 128 * 64 + lane;
    float c0 = 0.f, c1 = 0.f;
#pragma unroll
    for (int q = 0; q < 16; ++q) { c0 += cbias[(kind * 16 + q) * 128 + lane]; c1 += cbias[(kind * 16 + q) * 128 + 64 + lane]; }
#pragma unroll
    for (int cc = 0; cc < 8; ++cc) { c0 += ch[(size_t)cc * 2048 * 128 + lane]; c1 += ch[(size_t)cc * 2048 * 128 + 64 + lane]; }
    c0 = siluf_(c0); c1 = siluf_(c1);
    float acc = 0.f;
#pragma unroll 8
    for (int h = 0; h < 64; ++h) acc += __shfl(c0, h) * w[h * 64];
#pragma unroll 8
    for (int h = 0; h < 64; ++h) acc += __shfl(c1, h) * w[(64 + h) * 64];
    if (n == 127) acc = 0.f;
    const bf16_t o = (bf16_t)(cvt_pk_bf16(acc, 0.f) & 0xffffu);
    if (kind == 0) KC[((size_t)bg * 128 + n) * 64 + lane] = o; else VTC[((size_t)bg * 64 + lane) * 128 + n] = o;
  }
}

#ifndef NSA_QT
#define NSA_QT 2
#endif
constexpr int NSA_TQ = 16 * NSA_QT;
constexpr bool NSA_QL = (NSA_QT == 2);
constexpr int NSA_SLOTS = ATT_TWO_TILES(64, NSA_QT) ? 4 : 2;
constexpr int N_IMP = 8 * NSA_TQ * 32 * 4, N_IMPF = NSA_TQ * 33 * 4;
constexpr int N_KL = NSA_SLOTS * 64 * 72 * 2, N_VL0 = NSA_SLOTS * 64 * VSTR * 2, N_VL = (N_KL + N_VL0 >= N_IMP + N_IMPF ? N_VL0 : ((N_IMP + N_IMPF - N_KL + 255) & ~255)), N_KC = 128 * 72 * 2, N_VC = 64 * 136 * 2, N_QL = NSA_QL ? 8 * NSA_QT * 2 * 64 * 16 : 0;
constexpr int O_KL = 0, O_VL = O_KL + N_KL, O_KC = O_VL + N_VL, O_VC = O_KC + N_KC, O_SEL = O_VC + N_VC, O_QL = O_SEL + 256, O_END = O_QL + N_QL;
constexpr int O_IMP = O_KL, O_IMPF = O_IMP + N_IMP;
static_assert(N_IMP + N_IMPF <= N_KL + N_VL, "NSA LDS alias");
static_assert(O_END <= LDS_BYTES - 256, "NSA LDS map");
DI void nsa_attn_phase(unsigned char* ws, LAS unsigned char* lds) {
#define Qb  ((const bf16_t*)(ws + WS_QB))
#define KC  ((const bf16_t*)(ws + WS_KC))
#define VTC ((const bf16_t*)(ws + WS_VTC))
#define KS  ((const bf16_t*)(ws + WS_KS))
#define VTS ((const bf16_t*)(ws + WS_VTS))
#define KW  ((const bf16_t*)(ws + WS_KW))
#define VTW ((const bf16_t*)(ws + WS_VTW))
#define GT  ((const float*)(ws + WS_GT))
#define YB  ((bf16_t*)(ws + WS_YB))
#define YF  ((float*)(ws + WS_YF))
  constexpr int QT = NSA_QT, TQ = NSA_TQ, NTB = SEQ / TQ;
  LAS bf16_t* Kl = (LAS bf16_t*)(lds + O_KL); LAS bf16_t* Vl = (LAS bf16_t*)(lds + O_VL);
  LAS bf16_t* Kc = (LAS bf16_t*)(lds + O_KC); LAS bf16_t* Vc = (LAS bf16_t*)(lds + O_VC);
  LAS float* IMP = (LAS float*)(lds + O_IMP); LAS float* IMPF = (LAS float*)(lds + O_IMPF); LAS unsigned* SEL = (LAS unsigned*)(lds + O_SEL);
  const int tid = otid(), lane = tid & 63, wv = __builtin_amdgcn_readfirstlane(tid >> 6), G = gridDim.x, c = blockIdx.x;
  LAS bf16_t* Ql = (LAS bf16_t*)(lds + O_QL) + (NSA_QL ? wv * (QT * 2 * 64 * 8) : 0);
  const int r = lane & 15, g4 = lane >> 4;
  const bool xl = (G & 15) == 0;
  const int nsl = xl ? (G >> 4) : G, slot = xl ? (c >> 4) : c, nun = xl ? NTB : NTB * 16;
  int last_bg = -1;
  for (int rnd = 0; rnd * nsl < nun; ++rnd) {
    const int v = (rnd & 1) ? (rnd + 1) * nsl - 1 - slot : rnd * nsl + slot;
    if (v >= nun) continue;
    const int tb = (NTB - 1) - (xl ? v : (v >> 4)), bg = xl ? ((c & 7) + 8 * ((c >> 3) & 1)) : (v & 15), b = bg >> 1, g = bg & 1;
    const int t0 = tb * TQ, head = g * 8 + wv;
    if (bg != last_bg) {
    for (int ch = tid; ch < 128 * 8; ch += 512) { const int row = ch >> 3, cc = ch & 7; *(LAS u32x4*)(Kc + row * 72 + cc * 8) = *(const u32x4*)(KC + ((size_t)bg * 128 + row) * 64 + cc * 8); }
    for (int ch = tid; ch < 64 * 16; ch += 512) { const int row = ch >> 4, cc = ch & 15; *(LAS u32x4*)(Vc + row * 136 + cc * 8) = *(const u32x4*)(VTC + ((size_t)bg * 64 + row) * 128 + cc * 8); }
    last_bg = bg; }
    if (tid == 0) SEL[32] = 0u;
    bf16x8 qf[QT][2]; int tq[QT];
    constexpr bool OFR = (NSA_QT == 1);
    f32x4 ofin[QT][4];
#pragma unroll
    for (int qt = 0; qt < QT; ++qt) {
      tq[qt] = t0 + qt * 16 + r;
      const size_t tok = (size_t)b * SEQ + tq[qt];
#pragma unroll
      for (int ks = 0; ks < 2; ++ks) { qf[qt][ks] = *(const bf16x8*)(Qb + tok * 1024 + head * 64 + ks * 32 + g4 * 8);
        if (NSA_QL) *(LAS bf16x8*)(Ql + ((qt * 2 + ks) * 64 + lane) * 8) = qf[qt][ks]; }
    }
    __syncthreads();
#ifndef NSA_REP_C
#define NSA_REP_C 1
#define NSA_REP_S 1
#define NSA_REP_W 1
#endif
    for (int repc = 0; repc < NSA_REP_C; ++repc) {
    {
      const int tlc = otid(); const int r = tlc & 15, g4 = (tlc >> 4) & 3, lane = tlc & 63;
#pragma unroll
      for (int qt = 0; qt < QT; ++qt) {
        f32x4 oc[4];
#pragma unroll
        for (int dt = 0; dt < 4; ++dt) oc[dt] = (f32x4){0.f, 0.f, 0.f, 0.f};
        f32x4 sc[8];
#pragma unroll
        for (int kt = 0; kt < 8; ++kt) {
          sc[kt] = (f32x4){0.f, 0.f, 0.f, 0.f};
#pragma unroll
          for (int ks = 0; ks < 2; ++ks) {
            const bf16x8 kf = *(const LAS bf16x8*)(Kc + (kt * 16 + r) * 72 + ks * 32 + g4 * 8);
            const bf16x8 qv = NSA_QL ? *(const LAS bf16x8*)(Ql + ((qt * 2 + ks) * 64 + lane) * 8) : qf[qt][ks];
            sc[kt] = MFMA16(kf, qv, sc[kt]);
          }
        }
        float mx = -1e30f;
#pragma unroll
        for (int kt = 0; kt < 8; ++kt)
#pragma unroll
          for (int i = 0; i < 4; ++i) {
            const int n = kt * 16 + g4 * 4 + i;
            const bool valid = (16 * n + 31 <= tq[qt]) && (n < 127);
            const float sv = valid ? sc[kt][i] : -1e30f;
            sc[kt][i] = sv; mx = fmaxf(mx, sv);
          }
        mx = fmaxf(mx, __shfl_xor(mx, 16)); mx = fmaxf(mx, __shfl_xor(mx, 32));
        float rsum = 0.f;
#pragma unroll
        for (int kt = 0; kt < 8; ++kt)
#pragma unroll
          for (int i = 0; i < 4; ++i) { const float sv = sc[kt][i]; const float pv = (sv > -1e29f) ? fast_exp2(sv - mx) : 0.f; sc[kt][i] = pv; rsum += pv; }
        rsum += __shfl_xor(rsum, 16); rsum += __shfl_xor(rsum, 32);
        const float inv = 1.f / fmaxf(rsum, 1e-20f);
        float prevb = 0.f;
#pragma unroll
        for (int kt = 0; kt < 8; ++kt) {
          sc[kt] = sc[kt] * inv;
          const float a = (sc[kt][0] + sc[kt][1]) + (sc[kt][2] + 0.5f * sc[kt][3]);
          const float bcur = 0.5f * sc[kt][3];
          const float up = __shfl(bcur, (lane + 48) & 63);
          const float wrap = __shfl(prevb, (lane + 48) & 63);
          IMP[(wv * TQ + qt * 16 + r) * 32 + kt * 4 + g4] = a + (g4 > 0 ? up : wrap);
          prevb = bcur;
        }
#pragma unroll
        for (int k4 = 0; k4 < 4; ++k4) {
          u32x4 w; w.x = cvt_pk_v(sc[2 * k4][0], sc[2 * k4][1]); w.y = cvt_pk_v(sc[2 * k4][2], sc[2 * k4][3]);
          w.z = cvt_pk_v(sc[2 * k4 + 1][0], sc[2 * k4 + 1][1]); w.w = cvt_pk_v(sc[2 * k4 + 1][2], sc[2 * k4 + 1][3]);
          const bf16x8 pb = __builtin_bit_cast(bf16x8, w);
#pragma unroll
          for (int dt = 0; dt < 4; ++dt) {
            const LAS bf16_t* vp = Vc + (dt * 16 + r) * 136 + k4 * 32 + 4 * g4;
            const u32x2 lo2 = *(const LAS u32x2*)vp, hi2 = *(const LAS u32x2*)(vp + 16);
            u32x4 vv; vv.x = lo2.x; vv.y = lo2.y; vv.z = hi2.x; vv.w = hi2.y;
            oc[dt] = MFMA16(__builtin_bit_cast(bf16x8, vv), pb, oc[dt]);
          }
        }
        { const float g0 = GT[((size_t)b * SEQ + tq[qt]) * 48 + head * 3 + 0];
          float* yf = YF + ((size_t)b * SEQ + tq[qt]) * 1024 + head * 64 + g4 * 4;
#pragma unroll
          for (int dt = 0; dt < 4; ++dt) { if (OFR) ofin[qt][dt] = oc[dt] * g0; else *(f32x4*)(yf + dt * 16) = oc[dt] * g0; } }
        asm volatile("" ::: "memory");
      }
    }
    __syncthreads();
    for (int idx = tid; idx < TQ * 32; idx += 512) {
      const int q = idx >> 5, j = idx & 31; float sgm = 0.f;
#pragma unroll
      for (int h = 0; h < 8; ++h) sgm += IMP[(h * TQ + q) * 32 + j];
      IMPF[q * 33 + j] = sgm;
    }
    __syncthreads();
    for (int idx = tid; idx < TQ * 32; idx += 512) {
      const int q = idx >> 5, j = idx & 31, t = t0 + q, cur = t >> 6;
      const bool forced = (j == 0) || (j == cur) || (j == cur - 1), causal = (j <= cur), cand = causal && !forced;
      const float my = IMPF[q * 33 + j];
      int rank = 0;
#pragma unroll
      for (int jj = 0; jj < 32; ++jj) {
        const float v = IMPF[q * 33 + jj];
        const bool cj = (jj <= cur) && !((jj == 0) || (jj == cur) || (jj == cur - 1));
        rank += (cj && (v > my || (v == my && jj < j))) ? 1 : 0;
      }
      const bool sbit = causal && (forced || cur < 8 || (cand && rank < 5));
      const unsigned long long bal = __ballot(sbit);
      if ((lane & 31) == 0) { const unsigned sl = (lane == 0) ? (unsigned)bal : (unsigned)(bal >> 32); SEL[q] = sl; __hip_atomic_fetch_or(&SEL[32], sl, __ATOMIC_RELAXED, __HIP_MEMORY_SCOPE_WORKGROUP); }
    }
    __syncthreads();
    }
    unsigned sel[QT];
#pragma unroll
    for (int qt = 0; qt < QT; ++qt) sel[qt] = SEL[qt * 16 + r];
    const unsigned uni = (unsigned)__builtin_amdgcn_readfirstlane((int)SEL[32]);
    {
      f32x4 o[QT][4]; float m[QT], l[QT];
#pragma unroll
      for (int qt = 0; qt < QT; ++qt) { m[qt] = -1e30f; l[qt] = 0.f;
#pragma unroll
        for (int dt = 0; dt < 4; ++dt) o[qt][dt] = (f32x4){0.f, 0.f, 0.f, 0.f}; }
      for (int reps = 0; reps < NSA_REP_S; ++reps) {
#pragma unroll
      for (int qt = 0; qt < QT; ++qt) { m[qt] = -1e30f; l[qt] = 0.f;
#pragma unroll
        for (int dt = 0; dt < 4; ++dt) o[qt][dt] = (f32x4){0.f, 0.f, 0.f, 0.f}; }
      attn_loop<64, QT, 1, NSA_QL>(o, m, l, qf, Ql, uni, KS + (size_t)bg * SEQ * 64, 64, VTS + (size_t)bg * 64 * SEQ, SEQ, Kl, Vl, tq, sel, t0, t0 + TQ - 1); }
#pragma unroll
      for (int qt = 0; qt < QT; ++qt) { const float sc1 = GT[((size_t)b * SEQ + tq[qt]) * 48 + head * 3 + 1] / fmaxf(l[qt], 1e-20f);
        float* yf = YF + ((size_t)b * SEQ + tq[qt]) * 1024 + head * 64 + g4 * 4;
#pragma unroll
        for (int dt = 0; dt < 4; ++dt) { if (OFR) ofin[qt][dt] = ofin[qt][dt] + o[qt][dt] * sc1; else *(f32x4*)(yf + dt * 16) = *(const f32x4*)(yf + dt * 16) + o[qt][dt] * sc1; } }
    }
    {
      f32x4 o[QT][4]; float m[QT], l[QT];
#pragma unroll
      for (int qt = 0; qt < QT; ++qt) { m[qt] = -1e30f; l[qt] = 0.f;
#pragma unroll
        for (int dt = 0; dt < 4; ++dt) o[qt][dt] = (f32x4){0.f, 0.f, 0.f, 0.f}; }
      const int jlo = (t0 - 511 > 0 ? t0 - 511 : 0) >> 6, jhi = (t0 + TQ - 1) >> 6;
      const unsigned remw = ((2u << jhi) - 1u) & ~((1u << jlo) - 1u);
      for (int repw = 0; repw < NSA_REP_W; ++repw) {
#pragma unroll
      for (int qt = 0; qt < QT; ++qt) { m[qt] = -1e30f; l[qt] = 0.f;
#pragma unroll
        for (int dt = 0; dt < 4; ++dt) o[qt][dt] = (f32x4){0.f, 0.f, 0.f, 0.f}; }
      attn_loop<64, QT, 2, NSA_QL>(o, m, l, qf, Ql, remw, KW + (size_t)bg * SEQ * 64, 64, VTW + (size_t)bg * 64 * SEQ, SEQ, Kl, Vl, tq, sel, t0, t0 + TQ - 1); }
#pragma unroll
      for (int qt = 0; qt < QT; ++qt) { const float sc2 = GT[((size_t)b * SEQ + tq[qt]) * 48 + head * 3 + 2] / fmaxf(l[qt], 1e-20f);
        const float* yf = YF + ((size_t)b * SEQ + tq[qt]) * 1024 + head * 64 + g4 * 4;
        bf16_t* dst = YB + ((size_t)b * SEQ + tq[qt]) * 1024 + head * 64 + g4 * 4;
#pragma unroll
        for (int dt = 0; dt < 4; ++dt) { const f32x4 v = (OFR ? ofin[qt][dt] : *(const f32x4*)(yf + dt * 16)) + o[qt][dt] * sc2; u32x2 w; w.x = cvt_pk_bf16(v[0], v[1]); w.y = cvt_pk_bf16(v[2], v[3]); *(u32x2*)(dst + dt * 16) = w; } }
    }
    __syncthreads();
  }
}
#undef Qb
#undef KC
#undef VTC
#undef KS
#undef VTS
#undef KW
#undef VTW
#undef GT
#undef YB
#undef YF

constexpr int P_KL = 0, P_VL = P_KL + 4 * 64 * 72 * 2, P_KC = P_VL + 4 * 64 * VSTR * 2, P_VC = P_KC + 128 * 72 * 2, P_SEL = P_VC + 64 * 136 * 2, P_IMPF = P_SEL + 256, P_END = P_IMPF + 32 * 33 * 4;
static_assert(P_END <= LDS_BYTES - 256, "NSA pair LDS map");
DI void nsa_attn_phase2(unsigned char* ws, LAS unsigned char* lds) {
#define Qb  ((const bf16_t*)(ws + WS_QB))
#define KC  ((const bf16_t*)(ws + WS_KC))
#define VTC ((const bf16_t*)(ws + WS_VTC))
#define KS  ((const bf16_t*)(ws + WS_KS))
#define VTS ((const bf16_t*)(ws + WS_VTS))
#define KW  ((const bf16_t*)(ws + WS_KW))
#define VTW ((const bf16_t*)(ws + WS_VTW))
#define GT  ((const float*)(ws + WS_GT))
#define YB  ((bf16_t*)(ws + WS_YB))
#define YF  ((float*)(ws + WS_YF))
  constexpr int TQ = 32, NTB = SEQ / TQ;
  LAS bf16_t* Kl = (LAS bf16_t*)(lds + P_KL); LAS bf16_t* Vl = (LAS bf16_t*)(lds + P_VL);
  LAS bf16_t* Kc = (LAS bf16_t*)(lds + P_KC); LAS bf16_t* Vc = (LAS bf16_t*)(lds + P_VC);
  LAS float* IMPF = (LAS float*)(lds + P_IMPF); LAS unsigned* SEL = (LAS unsigned*)(lds + P_SEL);
  const int tid = otid(), lane = tid & 63, wv = __builtin_amdgcn_readfirstlane(tid >> 6), G = gridDim.x, c = blockIdx.x;
  const int r = lane & 15, g4 = lane >> 4, tokl = r >> 3, hl = r & 7;
  const bool xl = (G & 15) == 0;
  const int nsl = xl ? (G >> 4) : G, slot = xl ? (c >> 4) : c, nun = xl ? NTB : NTB * 16;
  int last_bg = -1;
  for (int rnd = 0; rnd * nsl < nun; ++rnd) {
    const int v = (rnd & 1) ? (rnd + 1) * nsl - 1 - slot : rnd * nsl + slot;
    if (v >= nun) continue;
    const int tb = (NTB - 1) - (xl ? v : (v >> 4)), bg = xl ? (2 * (c & 7) + ((c >> 3) & 1)) : (v & 15), b = bg >> 1, g = bg & 1;
    const int t0 = tb * TQ, head = g * 8 + hl;
    if (bg != last_bg) {
      for (int ch = tid; ch < 128 * 8; ch += 512) { const int row = ch >> 3, cc = ch & 7; *(LAS u32x4*)(Kc + row * 72 + cc * 8) = *(const u32x4*)(KC + ((size_t)bg * 128 + row) * 64 + cc * 8); }
      for (int ch = tid; ch < 64 * 16; ch += 512) { const int row = ch >> 4, cc = ch & 15; *(LAS u32x4*)(Vc + row * 136 + cc * 8) = *(const u32x4*)(VTC + ((size_t)bg * 64 + row) * 128 + cc * 8); }
      last_bg = bg; }
    if (tid == 0) SEL[32] = 0u;
    bf16x8 qf[2][1][2]; int tq[2][1];
#pragma unroll
    for (int s = 0; s < 2; ++s) {
      tq[s][0] = t0 + 4 * wv + 2 * s + tokl;
      const size_t tok = (size_t)b * SEQ + tq[s][0];
#pragma unroll
      for (int ks = 0; ks < 2; ++ks) qf[s][0][ks] = *(const bf16x8*)(Qb + tok * 1024 + head * 64 + ks * 32 + g4 * 8);
    }
    __syncthreads();
    {
    const int tlc = otid(); const int r = tlc & 15, g4 = (tlc >> 4) & 3, lane = tlc & 63, tokl = r >> 3, hl = r & 7;
#pragma unroll
    for (int s = 0; s < 2; ++s) {
      f32x4 oc[4];
#pragma unroll
      for (int dt = 0; dt < 4; ++dt) oc[dt] = (f32x4){0.f, 0.f, 0.f, 0.f};
      f32x4 sc[8];
#pragma unroll
      for (int kt = 0; kt < 8; ++kt) {
        sc[kt] = (f32x4){0.f, 0.f, 0.f, 0.f};
#pragma unroll
        for (int ks = 0; ks < 2; ++ks) {
          const bf16x8 kf = *(const LAS bf16x8*)(Kc + (kt * 16 + r) * 72 + ks * 32 + g4 * 8);
          sc[kt] = MFMA16(kf, qf[s][0][ks], sc[kt]);
        }
      }
      float mx = -1e30f;
#pragma unroll
      for (int kt = 0; kt < 8; ++kt)
#pragma unroll
        for (int i = 0; i < 4; ++i) {
          const int n = kt * 16 + g4 * 4 + i;
          const bool valid = (16 * n + 31 <= tq[s][0]) && (n < 127);
          const float sv = valid ? sc[kt][i] : -1e30f;
          sc[kt][i] = sv; mx = fmaxf(mx, sv);
        }
      mx = fmaxf(mx, __shfl_xor(mx, 16)); mx = fmaxf(mx, __shfl_xor(mx, 32));
      float rsum = 0.f;
#pragma unroll
      for (int kt = 0; kt < 8; ++kt)
#pragma unroll
        for (int i = 0; i < 4; ++i) { const float sv = sc[kt][i]; const float pv = (sv > -1e29f) ? fast_exp2(sv - mx) : 0.f; sc[kt][i] = pv; rsum += pv; }
      rsum += __shfl_xor(rsum, 16); rsum += __shfl_xor(rsum, 32);
      const float inv = 1.f / fmaxf(rsum, 1e-20f);
      float prevb = 0.f;
#pragma unroll
      for (int kt = 0; kt < 8; ++kt) {
        sc[kt] = sc[kt] * inv;
        const float a = (sc[kt][0] + sc[kt][1]) + (sc[kt][2] + 0.5f * sc[kt][3]);
        const float bcur = 0.5f * sc[kt][3];
        const float up = __shfl(bcur, (lane + 48) & 63);
        const float wrap = __shfl(prevb, (lane + 48) & 63);
        float impv = a + (g4 > 0 ? up : wrap);
        impv += __shfl_xor(impv, 1); impv += __shfl_xor(impv, 2); impv += __shfl_xor(impv, 4);
        if (hl == 0) IMPF[(4 * wv + 2 * s + tokl) * 33 + kt * 4 + g4] = impv;
        prevb = bcur;
      }
#pragma unroll
      for (int k4 = 0; k4 < 4; ++k4) {
        u32x4 w; w.x = cvt_pk_v(sc[2 * k4][0], sc[2 * k4][1]); w.y = cvt_pk_v(sc[2 * k4][2], sc[2 * k4][3]);
        w.z = cvt_pk_v(sc[2 * k4 + 1][0], sc[2 * k4 + 1][1]); w.w = cvt_pk_v(sc[2 * k4 + 1][2], sc[2 * k4 + 1][3]);
        const bf16x8 pb = __builtin_bit_cast(bf16x8, w);
#pragma unroll
        for (int dt = 0; dt < 4; ++dt) {
          const LAS bf16_t* vp = Vc + (dt * 16 + r) * 136 + k4 * 32 + 4 * g4;
          const u32x2 lo2 = *(const LAS u32x2*)vp, hi2 = *(const LAS u32x2*)(vp + 16);
          u32x4 vv; vv.x = lo2.x; vv.y = lo2.y; vv.z = hi2.x; vv.w = hi2.y;
          oc[dt] = MFMA16(__builtin_bit_cast(bf16x8, vv), pb, oc[dt]);
        }
      }
      { const float g0 = GT[((size_t)b * SEQ + tq[s][0]) * 48 + head * 3 + 0];
        float* yf = YF + ((size_t)b * SEQ + tq[s][0]) * 1024 + head * 64 + g4 * 4;
#pragma unroll
        for (int dt = 0; dt < 4; ++dt) *(f32x4*)(yf + dt * 16) = oc[dt] * g0; }
      asm volatile("" ::: "memory");
    }
    }
    __syncthreads();
    for (int idx = tid; idx < TQ * 32; idx += 512) {
      const int q = idx >> 5, j = idx & 31, t = t0 + q, cur = t >> 6;
      const bool forced = (j == 0) || (j == cur) || (j == cur - 1), causal = (j <= cur), cand = causal && !forced;
      const float my = IMPF[q * 33 + j];
      int rank = 0;
#pragma unroll
      for (int jj = 0; jj < 32; ++jj) {
        const float vv = IMPF[q * 33 + jj];
        const bool cj = (jj <= cur) && !((jj == 0) || (jj == cur) || (jj == cur - 1));
        rank += (cj && (vv > my || (vv == my && jj < j))) ? 1 : 0;
      }
      const bool sbit = causal && (forced || cur < 8 || (cand && rank < 5));
      const unsigned long long bal = __ballot(sbit);
      if ((lane & 31) == 0) { const unsigned sl = (lane == 0) ? (unsigned)bal : (unsigned)(bal >> 32); SEL[q] = sl; __hip_atomic_fetch_or(&SEL[32], sl, __ATOMIC_RELAXED, __HIP_MEMORY_SCOPE_WORKGROUP); }
    }
    __syncthreads();
    unsigned sel[2][1];
#pragma unroll
    for (int s = 0; s < 2; ++s) sel[s][0] = SEL[4 * wv + 2 * s + tokl];
    const unsigned uni = (unsigned)__builtin_amdgcn_readfirstlane((int)SEL[32]);
    const int tmA = t0 + 4 * wv, tmB = tmA + 2;
    {
      f32x4 oA[1][4], oB[1][4]; float mA[1] = {-1e30f}, lA[1] = {0.f}, mB[1] = {-1e30f}, lB[1] = {0.f};
#pragma unroll
      for (int dt = 0; dt < 4; ++dt) { oA[0][dt] = (f32x4){0.f, 0.f, 0.f, 0.f}; oB[0][dt] = (f32x4){0.f, 0.f, 0.f, 0.f}; }
      attn_loop_pair<1>(oA, mA, lA, qf[0], tq[0], sel[0], tmA, tmA + 1, oB, mB, lB, qf[1], tq[1], sel[1], tmB, tmB + 1,
                        uni, KS + (size_t)bg * SEQ * 64, 64, VTS + (size_t)bg * 64 * SEQ, SEQ, Kl, Vl);
      const float sA = GT[((size_t)b * SEQ + tq[0][0]) * 48 + head * 3 + 1] / fmaxf(lA[0], 1e-20f), sB = GT[((size_t)b * SEQ + tq[1][0]) * 48 + head * 3 + 1] / fmaxf(lB[0], 1e-20f);
      float* yfA = YF + ((size_t)b * SEQ + tq[0][0]) * 1024 + head * 64 + g4 * 4; float* yfB = YF + ((size_t)b * SEQ + tq[1][0]) * 1024 + head * 64 + g4 * 4;
#pragma unroll
      for (int dt = 0; dt < 4; ++dt) { *(f32x4*)(yfA + dt * 16) = *(const f32x4*)(yfA + dt * 16) + oA[0][dt] * sA; *(f32x4*)(yfB + dt * 16) = *(const f32x4*)(yfB + dt * 16) + oB[0][dt] * sB; }
    }
    {
      f32x4 oA[1][4], oB[1][4]; float mA[1] = {-1e30f}, lA[1] = {0.f}, mB[1] = {-1e30f}, lB[1] = {0.f};
#pragma unroll
      for (int dt = 0; dt < 4; ++dt) { oA[0][dt] = (f32x4){0.f, 0.f, 0.f, 0.f}; oB[0][dt] = (f32x4){0.f, 0.f, 0.f, 0.f}; }
      const int jlo = (t0 - 511 > 0 ? t0 - 511 : 0) >> 6, jhi = (t0 + TQ - 1) >> 6;
      const unsigned remw = ((2u << jhi) - 1u) & ~((1u << jlo) - 1u);
      attn_loop_pair<2>(oA, mA, lA, qf[0], tq[0], sel[0], tmA, tmA + 1, oB, mB, lB, qf[1], tq[1], sel[1], tmB, tmB + 1,
                        remw, KW + (size_t)bg * SEQ * 64, 64, VTW + (size_t)bg * 64 * SEQ, SEQ, Kl, Vl);
      const float sA = GT[((size_t)b * SEQ + tq[0][0]) * 48 + head * 3 + 2] / fmaxf(lA[0], 1e-20f), sB = GT[((size_t)b * SEQ + tq[1][0]) * 48 + head * 3 + 2] / fmaxf(lB[0], 1e-20f);
      const float* yfA = YF + ((size_t)b * SEQ + tq[0][0]) * 1024 + head * 64 + g4 * 4; const float* yfB = YF + ((size_t)b * SEQ + tq[1][0]) * 1024 + head * 64 + g4 * 4;
      bf16_t* dA = YB + ((size_t)b * SEQ + tq[0][0]) * 1024 + head * 64 + g4 * 4; bf16_t* dB = YB + ((size_t)b * SEQ + tq[1][0]) * 1024 + head * 64 + g4 * 4;
#pragma unroll
      for (int dt = 0; dt < 4; ++dt) {
        const f32x4 va = *(const f32x4*)(yfA + dt * 16) + oA[0][dt] * sA, vb = *(const f32x4*)(yfB + dt * 16) + oB[0][dt] * sB;
        u32x2 wa; wa.x = cvt_pk_bf16(va[0], va[1]); wa.y = cvt_pk_bf16(va[2], va[3]); *(u32x2*)(dA + dt * 16) = wa;
        u32x2 wb; wb.x = cvt_pk_bf16(vb[0], vb[1]); wb.y = cvt_pk_bf16(vb[2], vb[3]); *(u32x2*)(dB + dt * 16) = wb;
      }
    }
    __syncthreads();
  }
#undef Qb
#undef KC
#undef VTC
#undef KS
#undef VTS
#undef KW
#undef VTW
#undef GT
#undef YB
#undef YF
}

#define XB_TMO      128
#define XB_XCNT(j)  (256  + 64 * (j))
#define XB_XSUB(j)  (1280 + 64 * (j))
#define XB_XGEN(j)  (2304 + 64 * (j))
#define XB_TOP      3328
#define XB_TOPGEN   3392
#define XB_SPIN_CAP (1u << 22)
DI unsigned xb_ld(unsigned* p)              { return __hip_atomic_load(p, __ATOMIC_RELAXED, __HIP_MEMORY_SCOPE_AGENT); }
DI unsigned xb_add(unsigned* p, unsigned v) { return __hip_atomic_fetch_add(p, v, __ATOMIC_RELAXED, __HIP_MEMORY_SCOPE_AGENT); }
DI unsigned xb_xcc_id() { return (unsigned)__builtin_amdgcn_s_getreg((3 << 11) | 20) & 0xFu; }
#define XB_SPIN(cond, bar) do { unsigned _sp = 0; while (cond) { __builtin_amdgcn_s_sleep(1); \
    if ((++_sp & 255u) == 0u) { if (xb_ld(&(bar)[XB_TMO])) break; if (_sp > XB_SPIN_CAP) { atomicAdd(&(bar)[XB_TMO], 1u); break; } } } } while (0)
DI void xcd_barrier_complete(unsigned* bar, unsigned x, unsigned& nloc, unsigned& nx) {
    const unsigned G = gridDim.x * gridDim.y * gridDim.z;
    unsigned sum, cnt, mine, sp = 0u;
    for (;;) {
        sum = 0u; cnt = 0u; mine = 0u;
#pragma unroll
        for (unsigned j = 0; j < 16; ++j) { const unsigned c = xb_ld(&bar[XB_XCNT(j)]); sum += c; cnt += (c > 0u) ? 1u : 0u; mine = (j == x) ? c : mine; }
        if (sum == G) break;
        __builtin_amdgcn_s_sleep(1);
        if ((++sp & 255u) == 0u) { if (xb_ld(&bar[XB_TMO])) break; if (sp > XB_SPIN_CAP) { atomicAdd(&bar[XB_TMO], 1u); break; } }
    }
    nloc = mine > 0u ? mine : 1u; nx = cnt > 0u ? cnt : 1u;
}
DI void xcd_barrier(unsigned* bar, volatile LAS unsigned* st) {
    asm volatile("s_waitcnt vmcnt(0)" ::: "memory");
    __syncthreads();
    if (threadIdx.x == 0) {
        const unsigned x = xb_xcc_id();
        __builtin_amdgcn_s_waitcnt(0);
        unsigned nloc = st[0], nx = st[1];
        if (nloc == 0u) { xcd_barrier_complete(bar, x, nloc, nx); st[0] = nloc; st[1] = nx; }
        const unsigned old = xb_add(&bar[XB_XSUB(x)], 1u);
        const unsigned gen = old / nloc;
        if (old + 1u == (gen + 1u) * nloc) {
            __builtin_amdgcn_fence(__ATOMIC_RELEASE, "agent");
            asm volatile("s_waitcnt vmcnt(0)" ::: "memory");
            const unsigned og = xb_add(&bar[XB_TOP], 1u);
            const unsigned tg = og / nx;
            if (og + 1u == (tg + 1u) * nx) xb_add(&bar[XB_TOPGEN], 1u);
            else XB_SPIN(xb_ld(&bar[XB_TOPGEN]) == tg, bar);
            __builtin_amdgcn_fence(__ATOMIC_ACQUIRE, "agent");
            xb_add(&bar[XB_XGEN(x)], 1u);
            asm volatile("s_waitcnt vmcnt(0)" ::: "memory");
        } else {
            XB_SPIN(xb_ld(&bar[XB_XGEN(x)]) == gen, bar);
            __builtin_amdgcn_fence(__ATOMIC_ACQUIRE, "agent");
            asm volatile("s_waitcnt vmcnt(0)" ::: "memory");
        }
    }
    __syncthreads();
}

template <class Epi> DI void run_gemm(LAS unsigned char* lds, const bf16_t* A, int lda, const bf16_t* Bt, int M, int N, int K, const Epi& E, int crot = 0, int ldb = 0) {
  if (ldb == 0) ldb = K;
  asm volatile("" : "+s"(K), "+s"(lda), "+s"(N), "+s"(M), "+s"(ldb));
  pg8::Gemm g{A, Bt, M, N, K, lda, ldb};
  pg8::StaticOrder S; S.init(M, N, (int)gridDim.x, (int)((blockIdx.x + gridDim.x - crot) % gridDim.x));
  pg8::gemm_phase<Epi, pg8::StaticOrder, true, true>(lds, g, S, E);
}

#ifndef PHMASK
#define PHMASK 0xffffffffu
#endif
#define PH(k) ((PHMASK >> (k)) & 1u)
#ifndef DBLMASK
#define DBLMASK 0u
#endif
#define REP(k) for (int r_ = 0; r_ < 1 + (int)((DBLMASK >> (k)) & 1u); ++r_)
#ifndef EXTRA_SYNCS
#define EXTRA_SYNCS 0
#endif
typedef const __attribute__((address_space(4))) Params* KP;
DI KP kparams() { KP kp = (KP)__builtin_amdgcn_kernarg_segment_ptr(); asm volatile("" : "+s"(kp)); return kp; }
#define WSP(type, off) ((type*)(kparams()->ws + (off)))
#define MODL(l) (WSP(float, WS_MOD) + (size_t)(l) * NB * NMOD)
#define XB_ST ((volatile LAS unsigned*)(lds + LDS_BYTES - 64))
#ifndef USE_CG_SYNC
#define GSYNC() xcd_barrier(WSP(unsigned, WS_BAR), XB_ST)
#else
#define GSYNC() grid.sync()
#endif
__global__ void __launch_bounds__(512, 2) mega(Params p_unused) {
  extern __shared__ __attribute__((aligned(16))) unsigned char lds_raw[];
  LAS unsigned char* lds = (LAS unsigned char*)lds_raw;
  cg::grid_group grid = cg::this_grid();
  { unsigned* bar0 = WSP(unsigned, WS_BAR);
    if (threadIdx.x == 0) { XB_ST[0] = 0u; XB_ST[1] = 0u; (void)xb_add(&bar0[XB_XCNT(xb_xcc_id())], 1u); } }
  __syncthreads();

  REP(0) if (PH(0)) {
    LAS float* tile = (LAS float*)lds;
    int rot = 0;
#ifndef PREP_REP_T
#define PREP_REP_T 1
#endif
    for (int rt_ = 0; rt_ < PREP_REP_T; ++rt_) {
    for (int i = 0; i < 8; ++i) {
      prep_transpose<1, 256, true>(kparams()->ff_w13 + (size_t)i * D * 2 * DFF, D, 2 * DFF, WSP(bf16_t, WS_WT13) + (size_t)i * 2 * DFF * D, 2 * DFF, tile, rot);
      prep_transpose<0, 256, true>(kparams()->ff_w2 + (size_t)i * DFF * D, DFF, D, WSP(bf16_t, WS_WT2) + (size_t)i * D * DFF, D, tile, rot);
    }
    for (int m = 0; m < 2; ++m) {
      prep_transpose<0, 256, true>(kparams()->hy_w_in + (size_t)m * D * HY_IN, D, HY_IN, WSP(bf16_t, WS_WTHI) + (size_t)m * 2048 * D, 2048, tile, rot);
      prep_transpose<2, 256, false>(kparams()->hy_w_uq + (size_t)m * 256 * 768, 256, 768, WSP(bf16_t, WS_WTUQ) + (size_t)m * 768 * 256, 768, tile, rot);
      prep_transpose<0, 128, true>(kparams()->hy_w_ukv + (size_t)m * 128 * 1024, 128, 1024, WSP(bf16_t, WS_WTUKV) + (size_t)m * 1024 * 128, 1024, tile, rot);
      prep_transpose<0, 256, true>(kparams()->hy_w_out + (size_t)m * D * D, D, D, WSP(bf16_t, WS_WTHO) + (size_t)m * D * D, D, tile, rot);
      prep_transpose<0, 256, true>(kparams()->nsa_w_in + (size_t)m * D * NSA_IN, D, NSA_IN, WSP(bf16_t, WS_WTNI) + (size_t)m * 2048 * D, 2048, tile, rot);
      prep_transpose<0, 256, true>(kparams()->nsa_w_out + (size_t)m * D * D, D, D, WSP(bf16_t, WS_WTNO) + (size_t)m * D * D, D, tile, rot);
      for (int kind = 0; kind < 2; ++kind)
        prep_transpose<0, 256, true>(kparams()->nsa_cmp_w1 + (size_t)(m * 2 + kind) * 2048 * 128, 2048, 128, WSP(bf16_t, WS_WTC1) + (size_t)(m * 2 + kind) * 256 * 2048, 256, tile, rot);
    }
    }
    prep_adaln(kparams()->c, kparams()->ada_w, kparams()->ada_b, WSP(float, WS_MOD), tile);
    prep_misc(kparams()->positions, kparams()->nsa_cmp_pe, kparams()->nsa_cmp_w1, WSP(float, WS_ROPE), WSP(float, WS_ROPE) + (size_t)T * 16, WSP(float, WS_CBIAS), tile);
  }
  grid.sync();

  for (int l = 0; l < NLAYER; ++l) {
    const int mi = l >> 1;
    for (int sub = 0; sub < 3; ++sub) {
      const bool first = (l == 0 && sub == 0);
      REP(1) if (PH(1)) { const float* xin = first ? kparams()->x : WSP(float, WS_X);
        norm_phase<0>(xin, kparams()->norm_g + (size_t)(l * 3 + sub) * D, MODL(l) + (3 * sub) * D, MODL(l) + (3 * sub + 1) * D, WSP(bf16_t, WS_HB), nullptr); }
      GSYNC();
      if (sub != 1) {
        const int f = l * 2 + (sub >> 1);
        REP(2) if (PH(2)) { EpiSwiglu E{WSP(bf16_t, WS_UB)}; run_gemm(lds, WSP(bf16_t, WS_HB), D, WSP(bf16_t, WS_WT13) + (size_t)f * 2 * DFF * D, T, 2 * DFF, D, E); }
        GSYNC();
        REP(3) if (PH(3)) { const float* xin = first ? kparams()->x : WSP(float, WS_X);
          EpiResid E{xin, (r_ == (int)((DBLMASK >> 3) & 1u)) ? WSP(float, WS_X) : WSP(float, WS_YF), MODL(l) + (3 * sub + 2) * D, 0.5f}; run_gemm(lds, WSP(bf16_t, WS_UB), DFF, WSP(bf16_t, WS_WT2) + (size_t)f * D * DFF, T, D, DFF, E); }
        GSYNC();
      } else if ((l & 1) == 0) {
        REP(4) if (PH(4)) { EpiPlain E{WSP(bf16_t, WS_Z), 2048}; run_gemm(lds, WSP(bf16_t, WS_HB), D, WSP(bf16_t, WS_WTHI) + (size_t)mi * 2048 * D, T, 2048, D, E); }
        GSYNC();
        REP(5) if (PH(5)) mla_prep_phase(WSP(bf16_t, WS_Z), kparams()->hy_conv_w + (size_t)mi * 3 * 512, kparams()->hy_q_norm + mi * 256, kparams()->hy_kv_norm + mi * 128,
                                  WSP(float, WS_ROPE), WSP(float, WS_ROPE) + (size_t)T * 16, WSP(bf16_t, WS_YB), WSP(bf16_t, WS_CQ), WSP(bf16_t, WS_CKV), WSP(bf16_t, WS_KB));
        GSYNC();
        REP(6) if (PH(6)) { EpiQRope E{WSP(bf16_t, WS_QB), WSP(float, WS_ROPE), WSP(float, WS_ROPE) + (size_t)T * 16, 0.10206207261596575f * LOG2E};
          run_gemm(lds, WSP(bf16_t, WS_CQ), 256, WSP(bf16_t, WS_WTUQ) + (size_t)mi * 768 * 256, T, 768, 256, E); }
        REP(7) if (PH(7)) { EpiMlaKV E{WSP(bf16_t, WS_KB), WSP(bf16_t, WS_VT)}; run_gemm(lds, WSP(bf16_t, WS_CKV), 128, WSP(bf16_t, WS_WTUKV) + (size_t)mi * 1024 * 128, T, 1024, 128, E); }
        GSYNC();
        REP(8) if (PH(8)) mla_attn_phase(WSP(bf16_t, WS_QB), WSP(bf16_t, WS_KB), WSP(bf16_t, WS_VT), WSP(bf16_t, WS_YB), lds);
        GSYNC();
        REP(9) if (PH(9)) { EpiResid E{WSP(float, WS_X), (r_ == (int)((DBLMASK >> 9) & 1u)) ? WSP(float, WS_X) : WSP(float, WS_YF), MODL(l) + 5 * D, 1.0f}; run_gemm(lds, WSP(bf16_t, WS_YB), D, WSP(bf16_t, WS_WTHO) + (size_t)mi * D * D, T, D, D, E); }
        GSYNC();
      } else {
        REP(10) if (PH(10)) { EpiNsaIn E{WSP(bf16_t, WS_QB), WSP(bf16_t, WS_KVC), WSP(bf16_t, WS_KS), WSP(bf16_t, WS_VTS), WSP(bf16_t, WS_KW), WSP(bf16_t, WS_VTW), WSP(float, WS_GT),
                                 kparams()->nsa_gate_b + mi * 48, 0.125f * LOG2E};
          run_gemm(lds, WSP(bf16_t, WS_HB), D, WSP(bf16_t, WS_WTNI) + (size_t)mi * 2048 * D, T, 2048, D, E); }
        GSYNC();
        REP(11) if (PH(11)) for (int kc = 0; kc < 16; ++kc) {
          const int kind = kc >> 3, ch = kc & 7;
          EpiCmp E{WSP(float, WS_CH) + (size_t)kc * 2048 * 128};
          run_gemm(lds, WSP(bf16_t, WS_KVC) + (size_t)kind * T * 128 + ch * 256, 1024, WSP(bf16_t, WS_WTC1) + (size_t)(mi * 2 + kind) * 256 * 2048 + ch * 256, 2048, 256, 256, E, kc * 8, 2048);
        }
        GSYNC();
        REP(12) if (PH(12)) nsa_cmp2_phase(WSP(float, WS_CH), WSP(float, WS_CBIAS) + mi * 2 * 16 * 128, kparams()->nsa_cmp_w2 + (size_t)mi * 2 * 128 * 64, WSP(bf16_t, WS_KC), WSP(bf16_t, WS_VTC), (LAS float*)lds);
        GSYNC();
#ifndef NSA_PAIR
#define NSA_PAIR 1
#endif
        REP(13) if (PH(13)) { if (NSA_PAIR) nsa_attn_phase2(kparams()->ws, lds); else nsa_attn_phase(kparams()->ws, lds); }
        GSYNC();
        REP(14) if (PH(14)) { EpiResid E{WSP(float, WS_X), (r_ == (int)((DBLMASK >> 14) & 1u)) ? WSP(float, WS_X) : WSP(float, WS_YF), MODL(l) + 5 * D, 1.0f}; run_gemm(lds, WSP(bf16_t, WS_YB), D, WSP(bf16_t, WS_WTNO) + (size_t)mi * D * D, T, D, D, E); }
        GSYNC();
      }
    }
  }
  for (int e_ = 0; e_ < EXTRA_SYNCS; ++e_) GSYNC();
  if (PH(15)) norm_phase<1>(WSP(float, WS_X), kparams()->final_g, nullptr, nullptr, nullptr, kparams()->out);
}

extern "C" void kernel_launch(void* const* d_in, const int* in_sizes, int n_in, void* d_out, int out_size, void* d_ws, size_t ws_size, hipStream_t stream) {
  static int grid = 0;
  if (grid == 0) {
    int dev = 0, cus = 0, per_cu = 0;
    if (hipGetDevice(&dev) != hipSuccess || hipDeviceGetAttribute(&cus, hipDeviceAttributeMultiprocessorCount, dev) != hipSuccess) { fprintf(stderr, "device query failed\n"); grid = -1; return; }
    if (hipFuncSetAttribute((const void*)mega, hipFuncAttributeMaxDynamicSharedMemorySize, LDS_BYTES) != hipSuccess) { fprintf(stderr, "hipFuncSetAttribute failed\n"); grid = -1; return; }
    if (hipOccupancyMaxActiveBlocksPerMultiprocessor(&per_cu, (const void*)mega, 512, LDS_BYTES) != hipSuccess || per_cu < 1) { fprintf(stderr, "occupancy query: %d\n", per_cu); }
    (void)hipGetLastError();
    if (ws_size < WS_END) { fprintf(stderr, "workspace too small: %zu < %zu\n", ws_size, (size_t)WS_END); grid = -1; return; }
    grid = cus;
  }
  if (grid < 0) return;
  (void)hipMemsetAsync((char*)d_ws + WS_MOD, 0, ZERO_BYTES, stream);
  Params p{};
  p.x = (const float*)d_in[0]; p.c = (const float*)d_in[1]; p.positions = (const int*)d_in[2]; p.ada_w = (const float*)d_in[3]; p.ada_b = (const float*)d_in[4];
  p.norm_g = (const float*)d_in[5]; p.final_g = (const float*)d_in[6]; p.ff_w13 = (const float*)d_in[7]; p.ff_w2 = (const float*)d_in[8]; p.hy_w_in = (const float*)d_in[9];
  p.hy_conv_w = (const float*)d_in[10]; p.hy_q_norm = (const float*)d_in[11]; p.hy_kv_norm = (const float*)d_in[12]; p.hy_w_uq = (const float*)d_in[13];
  p.hy_w_ukv = (const float*)d_in[14]; p.hy_w_out = (const float*)d_in[15]; p.nsa_w_in = (const float*)d_in[16]; p.nsa_cmp_pe = (const float*)d_in[17];
  p.nsa_cmp_w1 = (const float*)d_in[18]; p.nsa_cmp_w2 = (const float*)d_in[19]; p.nsa_gate_b = (const float*)d_in[20]; p.nsa_w_out = (const float*)d_in[21];
  p.out = (float*)d_out; p.ws = (unsigned char*)d_ws;
  void* args[] = {&p};
  hipError_t e = hipLaunchCooperativeKernel((const void*)mega, dim3(grid), dim3(512), args, LDS_BYTES, stream);
  if (e != hipSuccess) fprintf(stderr, "cooperative launch failed: %s (grid %d)\n", hipGetErrorString(e), grid);
}
```

```cpp
#include <hip/hip_runtime.h>
#include <hip/hip_cooperative_groups.h>
#include <cstdio>
#include <cstdint>
namespace cg = cooperative_groups;
namespace pg8 {
#define PG8_LAS __attribute__((address_space(3)))
typedef unsigned short bf16_t;
typedef short bf16x8 __attribute__((ext_vector_type(8)));
typedef float f32x4 __attribute__((ext_vector_type(4)));
typedef unsigned u32x4 __attribute__((ext_vector_type(4)));
constexpr int BM = 256, BK = 64, HALF = 128, HTB = HALF * BK * 2  , STAGE_BYTES = 8 * HTB, NXCD = 8, WGM = 4;

__host__ __device__ __forceinline__ int lds_byte(int r, int c) { const int st = (r >> 4) * 2 + (c >> 5), rr = r & 15, cc = c & 31, ob = rr * 64 + cc * 2; return st * 1024 + (ob ^ (((ob >> 9) & 1) << 5)); }
__host__ __device__ __forceinline__ void stage_rc(int b, int& R, int& C) { const int st = b / 1024, sb = b % 1024, swz = sb ^ (((sb >> 9) & 1) << 5); R = (st >> 1) * 16 + swz / 64; C = (st & 1) * 32 + (swz % 64) / 2; }
__host__ __device__ __forceinline__ int perm32(int rho) { const int n = rho >> 4, i = rho & 15; return 8 * (i >> 2) + 4 * n + (i & 3); }

struct Unit { int pm, pn; };
struct Gemm { const bf16_t* A; const bf16_t* Bt; int M, N, K, lda, ldb; };

struct StaticOrder {
    int nM, nN, nwg, G, c;
    __host__ __device__ void init(int M, int N, int G_, int c_) { nM = M / BM; nN = N / BM; nwg = nM * nN; G = G_; c = c_; }
    __host__ __device__ bool next(int i, Unit& u) const {
        const long L = (long)i * G + c; if (L >= nwg) return false;
        int wgid = (int)L; { const int q = nwg / NXCD, r = nwg % NXCD, xcd = wgid % NXCD, off = wgid / NXCD; wgid = (xcd < r ? xcd * (q + 1) : r * (q + 1) + (xcd - r) * q) + off; }
        const int nig = WGM * nN, gid = wgid / nig, fm = gid * WGM, gsz = (nM - fm) < WGM ? (nM - fm) : WGM;
        u.pm = fm + ((wgid % nig) % gsz); u.pn = (wgid % nig) / gsz; return true;
    }
    __device__ __forceinline__ void a_ready(const Unit&) const {}
    __device__ __forceinline__ void done(const Unit&) const {}
};

__device__ __forceinline__ unsigned cvt_pk_bf16(float lo, float hi) { unsigned r; asm volatile("v_cvt_pk_bf16_f32 %0, %1, %2" : "=v"(r) : "v"(lo), "v"(hi)); return r; }

template <class Epi, class Sched, bool ALIGN_EPI = false, bool SP2 = false>
__device__ __forceinline__ void gemm_phase(PG8_LAS unsigned char* lds, const Gemm g, const Sched& S, const Epi& E) {
    int tid_ = threadIdx.x; asm volatile("" : "+v"(tid_));
    const int tid = tid_, wid = __builtin_amdgcn_readfirstlane(tid >> 6), lane = tid & 63, wr = wid >> 2, wc = wid & 3, fr = lane & 15, fq = lane >> 4;
    const int K = g.K, nt = K / BK;
    unsigned voffA[2], voffB[2];
#pragma unroll
    for (int i = 0; i < 2; ++i) { int R, C; stage_rc(tid * 16 + i * 8192, R, C); const int Rb = Epi::PERM ? ((R & ~31) + perm32(R & 31)) : R;
        voffA[i] = (unsigned)(R * g.lda + C) * 2u; voffB[i] = (unsigned)(Rb * g.ldb + C) * 2u; }
    const size_t kstep = (size_t)(BK * 2);
    const size_t hstep = (size_t)HALF * g.ldb * 2;
    const size_t tstep = 2 * hstep; const size_t hstepA = (size_t)HALF * g.lda * 2; const size_t tstepA = 2 * hstepA;
    const unsigned ldsw = (unsigned)wid * 1024u;
    const int aoff = lds_byte(wr * 64 + fr, fq * 8), boff = lds_byte(wc * 32 + fr, fq * 8);
#define PG8_SA(b, h) (((b) * 2 + (h)) * HTB)
#define PG8_SB(b, h) ((4 + (b) * 2 + (h)) * HTB)
#define PG8_STAGE(bufoff, gbase, voff) do { _Pragma("unroll") for (int _i = 0; _i < 2; ++_i) \
        __builtin_amdgcn_global_load_lds((const unsigned*)((const char*)(gbase) + (voff)[_i]), (PG8_LAS unsigned*)(lds + (bufoff) + ldsw + _i * 8192), 16, 0, 0); } while (0)
#define PG8_LDA(dst, b, h) do { _Pragma("unroll") for (int m = 0; m < 4; ++m) _Pragma("unroll") for (int k = 0; k < 2; ++k) dst[m][k] = *(const PG8_LAS bf16x8*)(lds + PG8_SA(b, h) + aoff + m * 2048 + k * 1024); } while (0)
#define PG8_LDB(dst, b, h) do { _Pragma("unroll") for (int n = 0; n < 2; ++n) _Pragma("unroll") for (int k = 0; k < 2; ++k) dst[n][k] = *(const PG8_LAS bf16x8*)(lds + PG8_SB(b, h) + boff + n * 2048 + k * 1024); } while (0)
#define PG8_MMA(ai, bj, At, Bt) do { __builtin_amdgcn_s_setprio(1); _Pragma("unroll") for (int m = 0; m < 4; ++m) _Pragma("unroll") for (int n = 0; n < 2; ++n) _Pragma("unroll") for (int k = 0; k < 2; ++k) \
        acc[ai][bj][m][n] = __builtin_amdgcn_mfma_f32_16x16x32_bf16(Bt[n][k], At[m][k], acc[ai][bj][m][n], 0, 0, 0); __builtin_amdgcn_s_setprio(0); } while (0)
#define PG8_WAIT_V(n) asm volatile("s_waitcnt vmcnt(" #n ")" ::: "memory")
#define PG8_WAIT_L(n) asm volatile("s_waitcnt lgkmcnt(" #n ")" ::: "memory")
#define PG8_BAR __builtin_amdgcn_s_barrier()
#define PG8_SCHED __builtin_amdgcn_sched_barrier(0)
    Unit cur, nxt; int ui = 0;
    if (!S.next(0, cur)) return;
    f32x4 acc[2][2][4][2];
#pragma unroll
    for (int a = 0; a < 2; ++a)
#pragma unroll
        for (int b = 0; b < 2; ++b)
#pragma unroll
            for (int m = 0; m < 4; ++m)
#pragma unroll
                for (int n = 0; n < 2; ++n) acc[a][b][m][n] = (f32x4){0.f, 0.f, 0.f, 0.f};
    bf16x8 At[4][2], B0[2][2], B1[2][2];
    const char* cA = (const char*)g.A + (size_t)cur.pm * tstepA; const char* cB = (const char*)g.Bt + (size_t)cur.pn * tstep;
    S.a_ready(cur);
    if constexpr (SP2) {
        PG8_STAGE(PG8_SB(0, 0), cB, voffB); PG8_STAGE(PG8_SB(0, 1), cB + hstep, voffB); PG8_STAGE(PG8_SA(0, 0), cA, voffA); PG8_STAGE(PG8_SA(0, 1), cA + hstepA, voffA);
        if (wr == 1) PG8_BAR;
        PG8_WAIT_V(2); PG8_BAR;
        PG8_STAGE(PG8_SB(1, 0), cB + kstep, voffB); PG8_STAGE(PG8_SA(1, 0), cA + kstep, voffA); PG8_STAGE(PG8_SB(1, 1), cB + hstep + kstep, voffB);
        PG8_WAIT_V(6); PG8_BAR;
    } else {
        PG8_STAGE(PG8_SB(0, 0), cB, voffB); PG8_STAGE(PG8_SA(0, 0), cA, voffA); PG8_STAGE(PG8_SB(0, 1), cB + hstep, voffB); PG8_STAGE(PG8_SA(0, 1), cA + hstepA, voffA);
        if (wr == 1) PG8_BAR;
        PG8_WAIT_V(4); PG8_BAR;
        PG8_STAGE(PG8_SB(1, 0), cB + kstep, voffB); PG8_STAGE(PG8_SA(1, 0), cA + kstep, voffA); PG8_STAGE(PG8_SB(1, 1), cB + hstep + kstep, voffB);
        PG8_WAIT_V(6); PG8_BAR;
    }
    for (;;) {
        const bool has_next = S.next(ui + 1, nxt);
        const char* nA = has_next ? (const char*)g.A + (size_t)nxt.pm * tstepA : cA; const char* nB = has_next ? (const char*)g.Bt + (size_t)nxt.pn * tstep : cB;
        for (int t = 0; t < nt; t += 2) {
            const bool last = (t == nt - 2);
            const char* a1 = cA + (size_t)(t + 1) * kstep;
            const char* a2 = last ? nA : cA + (size_t)(t + 2) * kstep; const char* b2 = last ? nB : cB + (size_t)(t + 2) * kstep;
            const char* a3 = a2 + kstep; const char* b3 = b2 + kstep;
            if (last && has_next) S.a_ready(nxt);
            if constexpr (SP2) {
            PG8_LDB(B0, 0, 0); PG8_LDB(B1, 0, 1); PG8_SCHED; PG8_LDA(At, 0, 0); PG8_STAGE(PG8_SA(1, 1), a1 + hstepA, voffA);
            PG8_WAIT_V(8); PG8_WAIT_L(0); PG8_BAR; PG8_MMA(0, 0, At, B0); PG8_MMA(0, 1, At, B1); PG8_BAR; PG8_SCHED;
            PG8_LDA(At, 0, 1); PG8_STAGE(PG8_SB(0, 0), b2, voffB); PG8_STAGE(PG8_SB(0, 1), b2 + hstep, voffB); PG8_STAGE(PG8_SA(0, 0), a2, voffA);
            PG8_WAIT_V(8); PG8_WAIT_L(0); PG8_BAR; PG8_MMA(1, 0, At, B0); PG8_MMA(1, 1, At, B1); PG8_BAR; PG8_SCHED;
            PG8_LDB(B0, 1, 0); PG8_LDB(B1, 1, 1); PG8_SCHED; PG8_LDA(At, 1, 0); PG8_STAGE(PG8_SA(0, 1), a2 + hstepA, voffA);
            PG8_WAIT_V(8); PG8_WAIT_L(0); PG8_BAR; PG8_MMA(0, 0, At, B0); PG8_MMA(0, 1, At, B1); PG8_BAR; PG8_SCHED;
            PG8_LDA(At, 1, 1); PG8_STAGE(PG8_SB(1, 0), b3, voffB); PG8_STAGE(PG8_SB(1, 1), b3 + hstep, voffB); PG8_STAGE(PG8_SA(1, 0), a3, voffA);
            PG8_WAIT_V(8); PG8_WAIT_L(0); PG8_BAR; PG8_MMA(1, 0, At, B0); PG8_MMA(1, 1, At, B1); PG8_BAR; PG8_SCHED;
            } else {
            PG8_LDB(B0, 0, 0); PG8_SCHED; PG8_LDA(At, 0, 0); PG8_STAGE(PG8_SA(1, 1), a1 + hstepA, voffA);
            PG8_WAIT_L(8); PG8_BAR; PG8_WAIT_L(0); PG8_MMA(0, 0, At, B0); PG8_BAR; PG8_SCHED;
            PG8_LDB(B1, 0, 1); PG8_STAGE(PG8_SB(0, 0), b2, voffB);
            PG8_BAR; PG8_WAIT_L(0); PG8_MMA(0, 1, At, B1); PG8_BAR;
            PG8_LDA(At, 0, 1); PG8_STAGE(PG8_SA(0, 0), a2, voffA);
            PG8_BAR; PG8_WAIT_L(0); PG8_MMA(1, 0, At, B0); PG8_BAR; PG8_SCHED;
            PG8_STAGE(PG8_SB(0, 1), b2 + hstep, voffB);
            PG8_WAIT_V(6); PG8_BAR; PG8_MMA(1, 1, At, B1); PG8_BAR;
            PG8_LDB(B0, 1, 0); PG8_SCHED; PG8_LDA(At, 1, 0); PG8_STAGE(PG8_SA(0, 1), a2 + hstepA, voffA);
            PG8_WAIT_L(8); PG8_BAR; PG8_WAIT_L(0); PG8_MMA(0, 0, At, B0); PG8_BAR; PG8_SCHED;
            PG8_LDB(B1, 1, 1); PG8_STAGE(PG8_SB(1, 0), b3, voffB);
            PG8_BAR; PG8_WAIT_L(0); PG8_MMA(0, 1, At, B1); PG8_BAR;
            PG8_LDA(At, 1, 1); PG8_STAGE(PG8_SA(1, 0), a3, voffA);
            PG8_BAR; PG8_WAIT_L(0); PG8_MMA(1, 0, At, B0); PG8_BAR; PG8_SCHED;
            PG8_STAGE(PG8_SB(1, 1), b3 + hstep, voffB);
            PG8_WAIT_V(6); PG8_BAR; PG8_MMA(1, 1, At, B1); PG8_BAR;
            }
        }
        if constexpr (ALIGN_EPI) { if (wr == 0) PG8_BAR; }
        if constexpr (!Epi::AFTER_DRAIN) { E(acc, cur, wr, wc, fr, fq); S.done(cur); }
        if (!has_next) break;
#pragma unroll
        for (int a = 0; a < 2; ++a)
#pragma unroll
            for (int b = 0; b < 2; ++b)
#pragma unroll
                for (int m = 0; m < 4; ++m)
#pragma unroll
                    for (int n = 0; n < 2; ++n) acc[a][b][m][n] = (f32x4){0.f, 0.f, 0.f, 0.f};
        cur = nxt; cA = nA; cB = nB; ++ui;
        if constexpr (ALIGN_EPI) { if (wr == 1) PG8_BAR; }
    }
    PG8_WAIT_V(0);
    if constexpr (!ALIGN_EPI) { if (wr == 0) PG8_BAR; }
    PG8_BAR;
    if constexpr (Epi::AFTER_DRAIN) { E.fused(acc, cur, wr, wc, fr, fq, lds, wid, lane); S.done(cur); }
#undef PG8_SA
#undef PG8_SB
#undef PG8_STAGE
#undef PG8_LDA
#undef PG8_LDB
#undef PG8_MMA
#undef PG8_WAIT_V
#undef PG8_WAIT_L
#undef PG8_BAR
#undef PG8_SCHED
}
}


#define DI __device__ __forceinline__
#define LAS __attribute__((address_space(3)))
using pg8::bf16_t; using pg8::bf16x8; using pg8::f32x4; using pg8::u32x4; using pg8::cvt_pk_bf16;
typedef short bf16x4 __attribute__((ext_vector_type(4)));
typedef unsigned u32x2 __attribute__((ext_vector_type(2)));

constexpr int NB = 8, SEQ = 2048, T = NB * SEQ, D = 1024, DFF = 2816, NLAYER = 4, NMOD = 9 * D;
constexpr int HY_IN = 1952, NSA_IN = 1840;
constexpr float EPS = 1e-6f;
constexpr float LOG2E = 1.4426950408889634f;
constexpr int LDS_BYTES = 147456;

constexpr size_t al256(size_t x) { return (x + 255) & ~(size_t)255; }
constexpr size_t WS_MOD   = 0;
constexpr size_t MOD_BYTES = (size_t)NLAYER * NB * NMOD * 4;
constexpr size_t WS_BAR   = WS_MOD + al256(MOD_BYTES);
constexpr size_t BAR_BYTES = 16384;
constexpr size_t ZERO_BYTES = al256(MOD_BYTES) + BAR_BYTES;
constexpr size_t WS_ROPE  = WS_BAR + BAR_BYTES;
constexpr size_t WS_CBIAS = WS_ROPE + al256((size_t)2 * T * 16 * 4);
constexpr size_t WS_WT13  = WS_CBIAS + al256(4 * 16 * 128 * 4);
constexpr size_t WS_WT2   = WS_WT13 + al256((size_t)8 * 5632 * 1024 * 2);
constexpr size_t WS_WTHI  = WS_WT2 + al256((size_t)8 * 1024 * 2816 * 2);
constexpr size_t WS_WTUQ  = WS_WTHI + al256((size_t)2 * 2048 * 1024 * 2);
constexpr size_t WS_WTUKV = WS_WTUQ + al256((size_t)2 * 768 * 256 * 2);
constexpr size_t WS_WTHO  = WS_WTUKV + al256((size_t)2 * 1024 * 128 * 2);
constexpr size_t WS_WTNI  = WS_WTHO + al256((size_t)2 * 1024 * 1024 * 2);
constexpr size_t WS_WTNO  = WS_WTNI + al256((size_t)2 * 2048 * 1024 * 2);
constexpr size_t WS_WTC1  = WS_WTNO + al256((size_t)2 * 1024 * 1024 * 2);
constexpr size_t WS_X     = WS_WTC1 + al256((size_t)4 * 256 * 2048 * 2);
constexpr size_t WS_HB    = WS_X + al256((size_t)T * D * 4);
constexpr size_t WS_UB    = WS_HB + al256((size_t)T * D * 2);
constexpr size_t WS_Z     = WS_UB + al256((size_t)T * DFF * 2);
constexpr size_t WS_CQ    = WS_Z + al256((size_t)T * 2048 * 2);
constexpr size_t WS_CKV   = WS_CQ + al256((size_t)T * 256 * 2);
constexpr size_t WS_QB    = WS_CKV + al256((size_t)T * 128 * 2);
constexpr size_t WS_KB    = WS_QB + al256((size_t)T * 1024 * 2);
constexpr size_t WS_VT    = WS_KB + al256((size_t)T * 768 * 2);
constexpr size_t WS_YB    = WS_VT + al256((size_t)T * 512 * 2);
constexpr size_t WS_KVC   = WS_YB + al256((size_t)T * 1024 * 2);
constexpr size_t WS_KS    = WS_KVC + al256((size_t)T * 256 * 2 + 8192);
constexpr size_t WS_VTS   = WS_KS + al256((size_t)T * 128 * 2);
constexpr size_t WS_KW    = WS_VTS + al256((size_t)T * 128 * 2);
constexpr size_t WS_VTW   = WS_KW + al256((size_t)T * 128 * 2);
constexpr size_t WS_GT    = WS_VTW + al256((size_t)T * 128 * 2);
constexpr size_t WS_CH    = WS_GT + al256((size_t)T * 48 * 4);
constexpr size_t WS_KC    = WS_CH + al256((size_t)16 * 2048 * 128 * 4);
constexpr size_t WS_VTC   = WS_KC + al256((size_t)16 * 128 * 64 * 2);
constexpr size_t WS_YF    = WS_VTC + al256((size_t)16 * 64 * 128 * 2);
constexpr size_t WS_END   = WS_YF + al256((size_t)T * 1024 * 4);

struct Params {
  const float* x; const float* c; const int* positions; const float* ada_w; const float* ada_b; const float* norm_g; const float* final_g;
  const float* ff_w13; const float* ff_w2; const float* hy_w_in; const float* hy_conv_w; const float* hy_q_norm; const float* hy_kv_norm;
  const float* hy_w_uq; const float* hy_w_ukv; const float* hy_w_out; const float* nsa_w_in; const float* nsa_cmp_pe; const float* nsa_cmp_w1;
  const float* nsa_cmp_w2; const float* nsa_gate_b; const float* nsa_w_out; float* out; unsigned char* ws;
};

DI int otid() { int t = threadIdx.x; asm volatile("" : "+v"(t)); return t; }
DI float wave_sum(float v) { v += __shfl_xor(v, 32); v += __shfl_xor(v, 16); v += __shfl_xor(v, 8); v += __shfl_xor(v, 4); v += __shfl_xor(v, 2); v += __shfl_xor(v, 1); return v; }
DI float bf2f(bf16_t h) { return __uint_as_float((unsigned)h << 16); }
DI float bflo(unsigned w) { return __uint_as_float(w << 16); }
DI float bfhi(unsigned w) { return __uint_as_float(w & 0xffff0000u); }
DI float fast_exp2(float x) { return __builtin_amdgcn_exp2f(x); }
DI float sigmoidf_(float x) { return __builtin_amdgcn_rcpf(1.f + __expf(-x)); }
DI float siluf_(float x) { return x * __builtin_amdgcn_rcpf(1.f + __expf(-x)); }
#define MFMA16(a, b, c) __builtin_amdgcn_mfma_f32_16x16x32_bf16((a), (b), (c), 0, 0, 0)

template <int MODE> DI int map_col(int n, int Nsrc) {
  if (MODE == 0) return n < Nsrc ? n : -1;
  if (MODE == 1) return ((n & 255) >> 7) * DFF + (n >> 8) * 128 + (n & 127);
  const int hh = n / 96, jj = n - hh * 96;
  return jj < 64 ? n : hh * 96 + 64 + ((jj - 64) & 1) * 16 + ((jj - 64) >> 1);
}
template <int MODE, int KT, bool VEC> DI void prep_transpose(const float* __restrict__ src, int K, int Nsrc, bf16_t* __restrict__ dst, int Ndst, LAS float* tile, int& rot) {
  const int G = gridDim.x, tid = otid();
  const int ntk = K / KT, nt = (Ndst >> 6) * ntk;
  int first = (int)blockIdx.x - rot; if (first < 0) first += G;
  if (VEC) {
    const int c4 = tid & 15, kr = tid >> 4;
    float4 v[KT / 32];
#define PT_LOAD(tt) do { const int tn_ = (tt) / ntk, tk_ = (tt) - tn_ * ntk; const int sc_ = map_col<MODE>(tn_ * 64 + c4 * 4, Nsrc); \
      _Pragma("unroll") for (int p = 0; p < KT / 32; ++p) v[p] = sc_ >= 0 ? *(const float4*)(src + (size_t)(tk_ * KT + p * 32 + kr) * Nsrc + sc_) : make_float4(0.f, 0.f, 0.f, 0.f); } while (0)
    if (first < nt) PT_LOAD(first);
    for (int t = first; t < nt; t += G) {
      const int tn = t / ntk, tk = t - tn * ntk, n0 = tn * 64, k0 = tk * KT;
#pragma unroll
      for (int p = 0; p < KT / 32; ++p) { LAS float* tp = tile + (p * 32 + kr) * 65 + c4 * 4; tp[0] = v[p].x; tp[1] = v[p].y; tp[2] = v[p].z; tp[3] = v[p].w; }
      __syncthreads();
      if (t + G < nt) PT_LOAD(t + G);
#pragma unroll
      for (int q = 0; q < KT / 64; ++q) {
        const int n = tid >> 3, kc = (tid & 7) + q * 8; float w8[8];
#pragma unroll
        for (int j = 0; j < 8; ++j) w8[j] = tile[(kc * 8 + j) * 65 + n];
        u32x4 w; w.x = cvt_pk_bf16(w8[0], w8[1]); w.y = cvt_pk_bf16(w8[2], w8[3]); w.z = cvt_pk_bf16(w8[4], w8[5]); w.w = cvt_pk_bf16(w8[6], w8[7]);
        *(u32x4*)(dst + (size_t)(n0 + n) * K + k0 + kc * 8) = w;
      }
      __syncthreads();
    }
#undef PT_LOAD
  } else {
  for (int t = first; t < nt; t += G) {
    const int tn = t / ntk, tk = t - tn * ntk, n0 = tn * 64, k0 = tk * KT;
    {
      const int kr = tid >> 6, nn = tid & 63; const int sc = map_col<MODE>(n0 + nn, Nsrc);
      float v[KT / 8];
#pragma unroll
      for (int p = 0; p < KT / 8; ++p) v[p] = sc >= 0 ? src[(size_t)(k0 + p * 8 + kr) * Nsrc + sc] : 0.f;
#pragma unroll
      for (int p = 0; p < KT / 8; ++p) tile[(p * 8 + kr) * 65 + nn] = v[p];
    }
    __syncthreads();
#pragma unroll
    for (int q = 0; q < KT / 64; ++q) {
      const int n = tid >> 3, kc = (tid & 7) + q * 8; float v[8];
#pragma unroll
      for (int j = 0; j < 8; ++j) v[j] = tile[(kc * 8 + j) * 65 + n];
      u32x4 w; w.x = cvt_pk_bf16(v[0], v[1]); w.y = cvt_pk_bf16(v[2], v[3]); w.z = cvt_pk_bf16(v[4], v[5]); w.w = cvt_pk_bf16(v[6], v[7]);
      *(u32x4*)(dst + (size_t)(n0 + n) * K + k0 + kc * 8) = w;
    }
    __syncthreads();
  }
  }
  rot = (rot + nt) % G;
}

DI void prep_adaln(const float* __restrict__ cvec, const float* __restrict__ ada_w, const float* __restrict__ ada_b, float* mod, LAS float* lbuf) {
  const int tid = otid();
  LAS float* cact = lbuf;
  LAS float* red = lbuf + 8 * 1024;
  for (int i = tid; i < 8 * 1024; i += 512) cact[i] = siluf_(cvec[i]);
  __syncthreads();
  const int col = tid & 31, kc = tid >> 5;
  for (int item = blockIdx.x; item < NLAYER * 288; item += gridDim.x) {
    const int l = item / 288, nc = item - l * 288;
    const int n = nc * 32 + col;
    float acc[8];
#pragma unroll
    for (int b = 0; b < 8; ++b) acc[b] = 0.f;
    const float* w = ada_w + ((size_t)l * D + kc * 64) * NMOD + n;
    for (int k0 = 0; k0 < 64; k0 += 32) {
      float wv[32];
#pragma unroll
      for (int k = 0; k < 32; ++k) wv[k] = w[(size_t)(k0 + k) * NMOD];
#pragma unroll
      for (int k = 0; k < 32; ++k)
#pragma unroll
        for (int b = 0; b < 8; ++b) acc[b] += cact[b * 1024 + kc * 64 + k0 + k] * wv[k];
    }
#pragma unroll
    for (int b = 0; b < 8; ++b) red[(kc * 8 + b) * 32 + col] = acc[b];
    __syncthreads();
    if (tid < 256) { const int b = tid >> 5; float s = ada_b[l * NMOD + n];
#pragma unroll
      for (int q = 0; q < 16; ++q) s += red[(q * 8 + b) * 32 + col];
      mod[(size_t)(l * NB + b) * NMOD + n] = s; }
    __syncthreads();
  }
}

DI void prep_misc(const int* __restrict__ positions, const float* __restrict__ cmp_pe, const float* __restrict__ cmp_w1, float* ropec, float* ropes, float* cbias, LAS float* scr) {
  const int tid = otid();
  const double inv_tab[16] = {1.0, 0.5623413251903491, 0.31622776601683794, 0.1778279410038923, 0.1, 0.05623413251903491, 0.03162277660168379, 0.01778279410038923,
                              0.01, 0.005623413251903491, 0.0031622776601683794, 0.0017782794100389228, 0.001, 0.0005623413251903491, 0.00031622776601683794, 0.00017782794100389227};
  for (int idx = blockIdx.x * 512 + tid; idx < T * 16; idx += gridDim.x * 512) {
    const int t = idx >> 4, i = idx & 15;
    double invd = 1.0;
#pragma unroll
    for (int j = 0; j < 16; ++j) if (i == j) invd = inv_tab[j];
    const float ang = (float)positions[t] * (float)invd;
    const double a = (double)ang;
    const double rev = a * 0.15915494309189535;
    const double fr = rev - __builtin_rint(rev);
    const float rr = (float)(fr * 6.283185307179586);
    ropec[idx] = __cosf(rr); ropes[idx] = __sinf(rr);
  }
  for (int item = blockIdx.x; item < 64; item += gridDim.x) {
    const int mk = item >> 4, chunk = item & 15, col = tid & 127, kq = tid >> 7;
    const float* pe = cmp_pe + (size_t)mk * 2048 + chunk * 128 + kq * 32; const float* w1 = cmp_w1 + ((size_t)mk * 2048 + chunk * 128 + kq * 32) * 128 + col;
    float s = 0.f;
#pragma unroll
    for (int k = 0; k < 32; ++k) s += pe[k] * w1[(size_t)k * 128];
    scr[tid] = s; __syncthreads();
    if (tid < 128) cbias[item * 128 + tid] = (scr[tid] + scr[tid + 128]) + (scr[tid + 256] + scr[tid + 384]);
    __syncthreads();
  }
}

template <int MODE> DI void norm_phase(const float* __restrict__ x, const float* __restrict__ g, const float* __restrict__ sh, const float* __restrict__ sc, bf16_t* outb, float* outf) {
  const int lane = otid() & 63, wv = otid() >> 6;
  const int G_ = (int)gridDim.x, c_ = (int)blockIdx.x; const bool xa_ = (G_ & 7) == 0;
  const int rbeg_ = xa_ ? (c_ & 7) * SEQ + (c_ >> 3) * 8 : c_ * 8, rend_ = xa_ ? (c_ & 7) * SEQ + SEQ : T, rstep_ = xa_ ? (G_ >> 3) * 8 : G_ * 8;
#pragma unroll 2
  for (int row = rbeg_ + wv; row < rend_; row += rstep_) {
    const int b = row >> 11;
    const float4* xr = (const float4*)(x + (size_t)row * D);
    float4 v[4]; float ss = 0.f;
#pragma unroll
    for (int i = 0; i < 4; ++i) { v[i] = xr[lane + 64 * i]; ss += v[i].x * v[i].x + v[i].y * v[i].y + v[i].z * v[i].z + v[i].w * v[i].w; }
    ss = wave_sum(ss);
    const float rstd = rsqrtf(ss * (1.f / D) + EPS);
#pragma unroll
    for (int i = 0; i < 4; ++i) {
      const int col = 4 * (lane + 64 * i);
      const float4 gg = *(const float4*)(g + col);
      if (MODE == 0) {
        const float4 s1 = *(const float4*)(sc + (size_t)b * NMOD + col), s0 = *(const float4*)(sh + (size_t)b * NMOD + col);
        const float h0 = v[i].x * rstd * gg.x * (1.f + s1.x) + s0.x, h1 = v[i].y * rstd * gg.y * (1.f + s1.y) + s0.y;
        const float h2 = v[i].z * rstd * gg.z * (1.f + s1.z) + s0.z, h3 = v[i].w * rstd * gg.w * (1.f + s1.w) + s0.w;
        u32x2 w; w.x = cvt_pk_bf16(h0, h1); w.y = cvt_pk_bf16(h2, h3);
        *(u32x2*)(outb + (size_t)row * D + col) = w;
      } else {
        float4 o; o.x = v[i].x * rstd * gg.x; o.y = v[i].y * rstd * gg.y; o.z = v[i].z * rstd * gg.z; o.w = v[i].w * rstd * gg.w;
        *(float4*)(outf + (size_t)row * D + col) = o;
      }
    }
  }
}
using pg8::Unit;
typedef f32x4 AccT[2][2][4][2];

struct EpiSwiglu {
  static constexpr bool PERM = true, AFTER_DRAIN = false;
  bf16_t* U;
  DI void operator()(const AccT& acc, const Unit& u, int wr, int wc, int fr, int fq) const {
    const int row0 = u.pm * 256 + wr * 64 + fr, col0 = u.pn * 128 + wc * 32 + 8 * fq;
#pragma unroll
    for (int ai = 0; ai < 2; ++ai)
#pragma unroll
      for (int m = 0; m < 4; ++m) {
        const f32x4 a0 = acc[ai][0][m][0], a1 = acc[ai][0][m][1], b0 = acc[ai][1][m][0], b1 = acc[ai][1][m][1];
        float h[8];
#pragma unroll
        for (int e = 0; e < 4; ++e) { h[e] = siluf_(a0[e]) * b0[e]; h[4 + e] = siluf_(a1[e]) * b1[e]; }
        u32x4 w; w.x = cvt_pk_bf16(h[0], h[1]); w.y = cvt_pk_bf16(h[2], h[3]); w.z = cvt_pk_bf16(h[4], h[5]); w.w = cvt_pk_bf16(h[6], h[7]);
        __builtin_nontemporal_store(w, (u32x4*)(U + (size_t)(row0 + ai * 128 + m * 16) * DFF + col0));
        asm volatile("" ::: "memory");
      }
  }
};

struct EpiResid {
  static constexpr bool PERM = true, AFTER_DRAIN = false;
  const float* xin; float* xout; const float* gate; float coef;
  DI void operator()(const AccT& acc, const Unit& u, int wr, int wc, int fr, int fq) const {
    const int row0 = u.pm * 256 + wr * 64 + fr, col0 = u.pn * 256 + wc * 32 + 8 * fq;
    const int b = (u.pm * 256) >> 11;
    f32x4 gv[2][2];
#pragma unroll
    for (int bj = 0; bj < 2; ++bj)
#pragma unroll
      for (int n = 0; n < 2; ++n) gv[bj][n] = *(const f32x4*)(gate + (size_t)b * NMOD + col0 + bj * 128 + 4 * n) * coef;
#pragma unroll
    for (int ai = 0; ai < 2; ++ai)
#pragma unroll
      for (int m = 0; m < 4; ++m) {
        const size_t ro = (size_t)(row0 + ai * 128 + m * 16) * D;
#pragma unroll
        for (int bj = 0; bj < 2; ++bj)
#pragma unroll
          for (int n = 0; n < 2; ++n) {
            const int c = col0 + bj * 128 + 4 * n;
            const f32x4 xv = *(const f32x4*)(xin + ro + c);
            *(f32x4*)(xout + ro + c) = xv + gv[bj][n] * acc[ai][bj][m][n];
          }
        asm volatile("" ::: "memory");
      }
  }
};

struct EpiPlain {
  static constexpr bool PERM = true, AFTER_DRAIN = false;
  bf16_t* O; int ldc;
  DI void operator()(const AccT& acc, const Unit& u, int wr, int wc, int fr, int fq) const {
    const int row0 = u.pm * 256 + wr * 64 + fr, col0 = u.pn * 256 + wc * 32 + 8 * fq;
#pragma unroll
    for (int ai = 0; ai < 2; ++ai)
#pragma unroll
      for (int m = 0; m < 4; ++m)
#pragma unroll
        for (int bj = 0; bj < 2; ++bj) {
          const f32x4 v0 = acc[ai][bj][m][0], v1 = acc[ai][bj][m][1];
          u32x4 w; w.x = cvt_pk_bf16(v0[0], v0[1]); w.y = cvt_pk_bf16(v0[2], v0[3]); w.z = cvt_pk_bf16(v1[0], v1[1]); w.w = cvt_pk_bf16(v1[2], v1[3]);
          *(u32x4*)(O + (size_t)(row0 + ai * 128 + m * 16) * ldc + col0 + bj * 128) = w;
          asm volatile("" ::: "memory");
        }
  }
};

struct EpiQRope {
  static constexpr bool PERM = true, AFTER_DRAIN = false;
  bf16_t* Q; const float* rc; const float* rs; float qscale;
  DI void operator()(const AccT& acc, const Unit& u, int wr, int wc, int fr, int fq) const {
    const int row0 = u.pm * 256 + wr * 64 + fr;
#pragma unroll
    for (int bj = 0; bj < 2; ++bj) {
      const int c32 = u.pn * 256 + bj * 128 + wc * 32;
      const bool rope = (c32 % 96) == 64;
      const int col0 = c32 + 8 * fq;
#pragma unroll
      for (int ai = 0; ai < 2; ++ai)
#pragma unroll
        for (int m = 0; m < 4; ++m) {
          const int row = row0 + ai * 128 + m * 16;
          f32x4 v0 = acc[ai][bj][m][0], v1 = acc[ai][bj][m][1];
          if (rope) {
            const f32x4 cs = *(const f32x4*)(rc + (size_t)row * 16 + 4 * fq), sn = *(const f32x4*)(rs + (size_t)row * 16 + 4 * fq);
            f32x4 r0, r1;
            r0[0] = v0[0] * cs[0] - v0[1] * sn[0]; r0[1] = v0[0] * sn[0] + v0[1] * cs[0];
            r0[2] = v0[2] * cs[1] - v0[3] * sn[1]; r0[3] = v0[2] * sn[1] + v0[3] * cs[1];
            r1[0] = v1[0] * cs[2] - v1[1] * sn[2]; r1[1] = v1[0] * sn[2] + v1[1] * cs[2];
            r1[2] = v1[2] * cs[3] - v1[3] * sn[3]; r1[3] = v1[2] * sn[3] + v1[3] * cs[3];
            v0 = r0; v1 = r1;
          }
          v0 = v0 * qscale; v1 = v1 * qscale;
          u32x4 w; w.x = cvt_pk_bf16(v0[0], v0[1]); w.y = cvt_pk_bf16(v0[2], v0[3]); w.z = cvt_pk_bf16(v1[0], v1[1]); w.w = cvt_pk_bf16(v1[2], v1[3]);
          *(u32x4*)(Q + (size_t)row * 768 + col0) = w;
          asm volatile("" ::: "memory");
        }
    }
  }
};

DI void store_vt8(bf16_t* vt_base  , const f32x4& v0, const f32x4& v1) {
  const unsigned w0 = cvt_pk_bf16(v0[0], v0[1]), w1 = cvt_pk_bf16(v0[2], v0[3]), w2 = cvt_pk_bf16(v1[0], v1[1]), w3 = cvt_pk_bf16(v1[2], v1[3]);
  vt_base[0 * SEQ] = (bf16_t)(w0 & 0xffffu); vt_base[1 * SEQ] = (bf16_t)(w0 >> 16);
  vt_base[2 * SEQ] = (bf16_t)(w1 & 0xffffu); vt_base[3 * SEQ] = (bf16_t)(w1 >> 16);
  vt_base[4 * SEQ] = (bf16_t)(w2 & 0xffffu); vt_base[5 * SEQ] = (bf16_t)(w2 >> 16);
  vt_base[6 * SEQ] = (bf16_t)(w3 & 0xffffu); vt_base[7 * SEQ] = (bf16_t)(w3 >> 16);
}

struct EpiMlaKV {
  static constexpr bool PERM = true, AFTER_DRAIN = false;
  bf16_t* Kb; bf16_t* Vt;
  DI void operator()(const AccT& acc, const Unit& u, int wr, int wc, int fr, int fq) const {
    const int row0 = u.pm * 256 + wr * 64 + fr;
    const int b = (u.pm * 256) >> 11;
#pragma unroll
    for (int bj = 0; bj < 2; ++bj) {
      const int h = u.pn * 2 + bj, j0 = wc * 32 + 8 * fq;
#pragma unroll
      for (int ai = 0; ai < 2; ++ai)
#pragma unroll
        for (int m = 0; m < 4; ++m) {
          const int row = row0 + ai * 128 + m * 16, s = row & (SEQ - 1);
          const f32x4 v0 = acc[ai][bj][m][0], v1 = acc[ai][bj][m][1];
          if (wc < 2) {
            u32x4 w; w.x = cvt_pk_bf16(v0[0], v0[1]); w.y = cvt_pk_bf16(v0[2], v0[3]); w.z = cvt_pk_bf16(v1[0], v1[1]); w.w = cvt_pk_bf16(v1[2], v1[3]);
            *(u32x4*)(Kb + (size_t)row * 768 + h * 96 + j0) = w;
          } else {
            store_vt8(Vt + ((size_t)(b * 8 + h) * 64 + (j0 - 64)) * SEQ + s, v0, v1);
          }
          asm volatile("" ::: "memory");
        }
    }
  }
};

struct EpiNsaIn {
  static constexpr bool PERM = true, AFTER_DRAIN = false;
  bf16_t* Q; bf16_t* KVC; bf16_t* KS; bf16_t* VTS; bf16_t* KW; bf16_t* VTW; float* GT; const float* gate_b; float qscale;
  DI void operator()(const AccT& acc, const Unit& u, int wr, int wc, int fr, int fq) const {
    const int row0 = u.pm * 256 + wr * 64 + fr;
    const int b = (u.pm * 256) >> 11;
    const int pn = u.pn;
#pragma unroll
    for (int bj = 0; bj < 2; ++bj) {
      const int cl = bj * 128 + wc * 32 + 8 * fq;
      const int g = wc >> 1, d0 = (wc & 1) * 32 + 8 * fq;
#pragma unroll
      for (int ai = 0; ai < 2; ++ai)
#pragma unroll
        for (int m = 0; m < 4; ++m) {
          const int row = row0 + ai * 128 + m * 16, s = row & (SEQ - 1);
          f32x4 v0 = acc[ai][bj][m][0], v1 = acc[ai][bj][m][1];
          if (pn < 4) {
            v0 = v0 * qscale; v1 = v1 * qscale;
            u32x4 w; w.x = cvt_pk_bf16(v0[0], v0[1]); w.y = cvt_pk_bf16(v0[2], v0[3]); w.z = cvt_pk_bf16(v1[0], v1[1]); w.w = cvt_pk_bf16(v1[2], v1[3]);
            *(u32x4*)(Q + (size_t)row * 1024 + pn * 256 + cl) = w;
          } else if (pn == 4) {
            u32x4 w; w.x = cvt_pk_bf16(v0[0], v0[1]); w.y = cvt_pk_bf16(v0[2], v0[3]); w.z = cvt_pk_bf16(v1[0], v1[1]); w.w = cvt_pk_bf16(v1[2], v1[3]);
            *(u32x4*)(KVC + ((size_t)((bj * 8 + b) * 2 + g) * SEQ + s) * 64 + d0) = w;
          } else if (pn < 7) {
            bf16_t* Kd = pn == 5 ? KS : KW; bf16_t* Vd = pn == 5 ? VTS : VTW;
            if (bj == 0) {
              u32x4 w; w.x = cvt_pk_bf16(v0[0], v0[1]); w.y = cvt_pk_bf16(v0[2], v0[3]); w.z = cvt_pk_bf16(v1[0], v1[1]); w.w = cvt_pk_bf16(v1[2], v1[3]);
              *(u32x4*)(Kd + ((size_t)(b * 2 + g) * SEQ + s) * 64 + d0) = w;
            } else {
              store_vt8(Vd + ((size_t)(b * 2 + g) * 64 + d0) * SEQ + s, v0, v1);
            }
          } else {
            if (cl < 48) {
              const f32x4 g0 = *(const f32x4*)(gate_b + cl), g1 = *(const f32x4*)(gate_b + cl + 4);
              f32x4 o0, o1;
#pragma unroll
              for (int e = 0; e < 4; ++e) { o0[e] = sigmoidf_(v0[e] + g0[e]); o1[e] = sigmoidf_(v1[e] + g1[e]); }
              *(f32x4*)(GT + (size_t)row * 48 + cl) = o0; *(f32x4*)(GT + (size_t)row * 48 + cl + 4) = o1;
            }
          }
          asm volatile("" ::: "memory");
        }
    }
  }
};

struct EpiCmp {
  static constexpr bool PERM = true, AFTER_DRAIN = false;
  float* CH;
  DI void operator()(const AccT& acc, const Unit& u, int wr, int wc, int fr, int fq) const {
    const int row0 = u.pm * 256 + wr * 64 + fr, col0 = wc * 32 + 8 * fq;
#pragma unroll
    for (int ai = 0; ai < 2; ++ai)
#pragma unroll
      for (int m = 0; m < 4; ++m) {
        float* dst = CH + (size_t)(row0 + ai * 128 + m * 16) * 128 + col0;
        *(f32x4*)dst = acc[ai][0][m][0]; *(f32x4*)(dst + 4) = acc[ai][0][m][1];
        asm volatile("" ::: "memory");
      }
  }
};
DI void mla_prep_phase(const bf16_t* __restrict__ Z, const float* __restrict__ conv_w, const float* __restrict__ qn, const float* __restrict__ kvn,
                       const float* __restrict__ rc, const float* __restrict__ rs, bf16_t* YB, bf16_t* CQ, bf16_t* CKV, bf16_t* Kb) {
  const int lane = otid() & 63, wv = otid() >> 6;
  const int G_ = (int)gridDim.x, c_ = (int)blockIdx.x; const bool xa_ = (G_ & 7) == 0;
  const int tbeg_ = xa_ ? (c_ & 7) * SEQ + (c_ >> 3) * 8 : c_ * 8, tend_ = xa_ ? (c_ & 7) * SEQ + SEQ : T, tstep_ = xa_ ? (G_ >> 3) * 8 : G_ * 8;
#pragma unroll 2
  for (int t = tbeg_ + wv; t < tend_; t += tstep_) {
    const int s = t & (SEQ - 1);
    const bf16_t* zr = Z + (size_t)t * 2048;
    {
      const int c0 = lane * 8;
      float accv[8];
#pragma unroll
      for (int e = 0; e < 8; ++e) accv[e] = 0.f;
#pragma unroll
      for (int j = 0; j < 3; ++j) {
        const int dt = 2 - j;
        if (s - dt >= 0) {
          const bf16_t* zz = zr - (size_t)dt * 2048;
          const u32x4 uu = *(const u32x4*)(zz + c0), gc = *(const u32x4*)(zz + 512 + c0);
          const float4 w0 = *(const float4*)(conv_w + j * 512 + c0), w1 = *(const float4*)(conv_w + j * 512 + c0 + 4);
          accv[0] += w0.x * bflo(uu.x) * bflo(gc.x); accv[1] += w0.y * bfhi(uu.x) * bfhi(gc.x);
          accv[2] += w0.z * bflo(uu.y) * bflo(gc.y); accv[3] += w0.w * bfhi(uu.y) * bfhi(gc.y);
          accv[4] += w1.x * bflo(uu.z) * bflo(gc.z); accv[5] += w1.y * bfhi(uu.z) * bfhi(gc.z);
          accv[6] += w1.z * bflo(uu.w) * bflo(gc.w); accv[7] += w1.w * bfhi(uu.w) * bfhi(gc.w);
        }
      }
      const u32x4 gb = *(const u32x4*)(zr + 1024 + c0);
      u32x4 w;
      w.x = cvt_pk_bf16(accv[0] * bflo(gb.x), accv[1] * bfhi(gb.x)); w.y = cvt_pk_bf16(accv[2] * bflo(gb.y), accv[3] * bfhi(gb.y));
      w.z = cvt_pk_bf16(accv[4] * bflo(gb.z), accv[5] * bfhi(gb.z)); w.w = cvt_pk_bf16(accv[6] * bflo(gb.w), accv[7] * bfhi(gb.w));
      *(u32x4*)(YB + (size_t)t * 1024 + c0) = w;
    }
    {
      const u32x2 q = *(const u32x2*)(zr + 1536 + lane * 4);
      const float a0 = bflo(q.x), a1 = bfhi(q.x), a2 = bflo(q.y), a3 = bfhi(q.y);
      const float ss = wave_sum(a0 * a0 + a1 * a1 + a2 * a2 + a3 * a3);
      const float rstd = rsqrtf(ss * (1.f / 256.f) + EPS);
      const float4 gg = *(const float4*)(qn + lane * 4);
      u32x2 w; w.x = cvt_pk_bf16(a0 * rstd * gg.x, a1 * rstd * gg.y); w.y = cvt_pk_bf16(a2 * rstd * gg.z, a3 * rstd * gg.w);
      *(u32x2*)(CQ + (size_t)t * 256 + lane * 4) = w;
    }
    {
      const unsigned q = *(const unsigned*)(zr + 1792 + lane * 2);
      const float a0 = bflo(q), a1 = bfhi(q);
      const float ss = wave_sum(a0 * a0 + a1 * a1);
      const float rstd = rsqrtf(ss * (1.f / 128.f) + EPS);
      const float2 gg = *(const float2*)(kvn + lane * 2);
      *(unsigned*)(CKV + (size_t)t * 128 + lane * 2) = cvt_pk_bf16(a0 * rstd * gg.x, a1 * rstd * gg.y);
    }
    if (lane < 16) {
      const float t1 = bf2f(zr[1920 + lane]), t2 = bf2f(zr[1936 + lane]);
      const float cs = rc[(size_t)t * 16 + lane], sn = rs[(size_t)t * 16 + lane];
      const unsigned w = cvt_pk_bf16(t1 * cs - t2 * sn, t1 * sn + t2 * cs);
#pragma unroll
      for (int h = 0; h < 8; ++h) *(unsigned*)(Kb + (size_t)t * 768 + h * 96 + 64 + 2 * lane) = w;
    }
  }
}

typedef float f32x2_t_ __attribute__((ext_vector_type(2)));
typedef __bf16 bf16x2_t_ __attribute__((ext_vector_type(2)));
DI unsigned cvt_pk_v(float lo, float hi) { f32x2_t_ v = {lo, hi}; bf16x2_t_ b = __builtin_convertvector(v, bf16x2_t_); return __builtin_bit_cast(unsigned, b); }
DI float max3f_(float a, float b, float c) { float r; asm("v_max3_f32 %0, %1, %2, %3" : "=v"(r) : "v"(a), "v"(b), "v"(c)); return r; }
DI float fsub_(float a, float b) { float r; asm("v_sub_f32_e32 %0, %1, %2" : "=v"(r) : "v"(a), "v"(b)); return r; }
DI float fadd_(float a, float b) { float r; asm("s_nop 0\n\tv_add_f32_e32 %0, %1, %2" : "=v"(r) : "v"(a), "v"(b)); return r; }
DI float fmul_(float a, float b) { float r; asm("s_nop 0\n\tv_mul_f32_e32 %0, %1, %2" : "=v"(r) : "v"(a), "v"(b)); return r; }
#ifndef ATT_TWO_TILES
#define ATT_TWO_TILES(dqk, qt) ((qt) == 1 || (dqk) == 96)
#endif
constexpr int VSTR = 72;
template <int KS, int KSTR, int QT, int MM, bool QLDS>
DI void attn_step(f32x4 (&o)[QT][4], float (&m)[QT], float (&l)[QT], const bf16x8 (&qf)[QT][KS], const LAS bf16_t* Ql, const LAS bf16_t* Kl, const LAS bf16_t* Vl,
                  int lane, int kbase, const int (&lo)[QT], const int (&hi)[QT]) {
  const int r = lane & 15, g = lane >> 4;
  f32x4 s[QT][4];
#pragma unroll
  for (int kt = 0; kt < 4; ++kt) {
#pragma unroll
    for (int qt = 0; qt < QT; ++qt) s[qt][kt] = (f32x4){0.f, 0.f, 0.f, 0.f};
#pragma unroll
    for (int ks = 0; ks < KS; ++ks) {
      const bf16x8 kf = *(const LAS bf16x8*)(Kl + (kt * 16 + r) * KSTR + ks * 32 + g * 8);
#pragma unroll
      for (int qt = 0; qt < QT; ++qt) {
        const bf16x8 qv = QLDS ? *(const LAS bf16x8*)(Ql + ((qt * KS + ks) * 64 + lane) * 8) : qf[qt][ks];
        s[qt][kt] = MFMA16(kf, qv, s[qt][kt]);
      }
    }
  }
#pragma unroll
  for (int qt = 0; qt < QT; ++qt) {
    if (qt == 0) asm volatile("s_nop 7\n\ts_nop 7" : "+v"(s[qt][0]), "+v"(s[qt][1]), "+v"(s[qt][2]), "+v"(s[qt][3]));
    else asm volatile("" : "+v"(s[qt][0]), "+v"(s[qt][1]), "+v"(s[qt][2]), "+v"(s[qt][3]));
  }
#pragma unroll
  for (int qt = 0; qt < QT; ++qt) {
    float mx = -1e30f;
    if (MM == 1) {
#pragma unroll
      for (int kt = 0; kt < 4; ++kt)
#pragma unroll
        for (int i = 0; i < 4; ++i) {
          const int key = kbase + kt * 16 + g * 4 + i;
          const bool valid = (key >= lo[qt]) && (key <= hi[qt]);
          const float sv = valid ? s[qt][kt][i] : -1e30f;
          s[qt][kt][i] = sv; mx = fmaxf(mx, sv);
        }
    } else {
#pragma unroll
      for (int kt = 0; kt < 4; ++kt) { mx = max3f_(mx, s[qt][kt][0], s[qt][kt][1]); mx = max3f_(mx, s[qt][kt][2], s[qt][kt][3]); }
      if (MM == 2) mx = (lo[qt] == 0) ? mx : -1e30f;
    }
    mx = max3f_(mx, __shfl_xor(mx, 16), -1e30f); mx = max3f_(mx, __shfl_xor(mx, 32), -1e30f);
    const float mn = max3f_(m[qt], mx, -1e30f);
    const float alpha = fast_exp2(m[qt] - mn);
    float rsum = 0.f;
    if (MM == 1) {
#pragma unroll
      for (int kt = 0; kt < 4; ++kt)
#pragma unroll
        for (int i = 0; i < 4; ++i) {
          const float sv = s[qt][kt][i];
          const float pv = (sv > -1e29f) ? fast_exp2(sv - mn) : 0.f;
          s[qt][kt][i] = pv; rsum += pv;
        }
    } else {
      const float mne = (MM == 2) ? ((lo[qt] == 0) ? mn : 1e30f) : mn;
      f32x4 ps = (f32x4){0.f, 0.f, 0.f, 0.f};
#pragma unroll
      for (int kt = 0; kt < 4; ++kt) {
        const f32x4 dv = s[qt][kt] - mne;
        f32x4 pv; pv[0] = fast_exp2(dv[0]); pv[1] = fast_exp2(dv[1]); pv[2] = fast_exp2(dv[2]); pv[3] = fast_exp2(dv[3]);
        s[qt][kt] = pv; ps = ps + pv;
      }
      rsum = (ps[0] + ps[1]) + (ps[2] + ps[3]);
    }
    rsum += __shfl_xor(rsum, 16); rsum += __shfl_xor(rsum, 32);
    l[qt] = l[qt] * alpha + rsum; m[qt] = mn;
    if (!__all(alpha == 1.0f)) {
#pragma unroll
      for (int dt = 0; dt < 4; ++dt) o[qt][dt] = o[qt][dt] * alpha;
    }
  }
#pragma unroll
  for (int k2 = 0; k2 < 2; ++k2) {
    bf16x8 pb[QT];
#pragma unroll
    for (int qt = 0; qt < QT; ++qt) {
      u32x4 w; w.x = cvt_pk_v(s[qt][2 * k2][0], s[qt][2 * k2][1]); w.y = cvt_pk_v(s[qt][2 * k2][2], s[qt][2 * k2][3]);
      w.z = cvt_pk_v(s[qt][2 * k2 + 1][0], s[qt][2 * k2 + 1][1]); w.w = cvt_pk_v(s[qt][2 * k2 + 1][2], s[qt][2 * k2 + 1][3]);
      pb[qt] = __builtin_bit_cast(bf16x8, w);
    }
#pragma unroll
    for (int dt = 0; dt < 4; ++dt) {
      const LAS bf16_t* vp = Vl + (dt * 16 + r) * VSTR + k2 * 32 + 4 * g;
      const u32x2 lo2 = *(const LAS u32x2*)vp, hi2 = *(const LAS u32x2*)(vp + 16);
      u32x4 vv; vv.x = lo2.x; vv.y = lo2.y; vv.z = hi2.x; vv.w = hi2.y;
      const bf16x8 vf = __builtin_bit_cast(bf16x8, vv);
#pragma unroll
      for (int qt = 0; qt < QT; ++qt) o[qt][dt] = MFMA16(vf, pb[qt], o[qt][dt]);
    }
  }
}

template <int DQK, int QT, int MODE, bool QLDS>
DI void attn_tile(f32x4 (&o)[QT][4], float (&m)[QT], float (&l)[QT], const bf16x8 (&qf)[QT][DQK / 32], const LAS bf16_t* Ql, const LAS bf16_t* Kl, const LAS bf16_t* Vl,
                  int j, const int (&tq)[QT], const unsigned (&sel)[QT], int twave_min, int twave_max) {
  constexpr int KSTR = DQK + 8, KS = DQK / 32;
  const int lane = otid() & 63;
  const int kbase = j * 64;
  if (MODE == 1) { bool anysel = false;
#pragma unroll
    for (int qt = 0; qt < QT; ++qt) anysel = anysel || ((sel[qt] >> j) & 1u);
    if (!__any(anysel)) return; }
  bool act;
  if (MODE == 2) act = (kbase + 63 >= twave_min - 511) && (kbase <= twave_max); else act = (kbase <= twave_max);
  if (act) {
    int lo[QT], hi[QT];
    bool full = true;
#pragma unroll
    for (int qt = 0; qt < QT; ++qt) {
      hi[qt] = tq[qt];
      if (MODE == 0) lo[qt] = 0; else if (MODE == 1) lo[qt] = ((sel[qt] >> j) & 1u) ? 0 : 0x7fffffff; else lo[qt] = tq[qt] - 511;
      full = full && (lo[qt] <= kbase) && (hi[qt] >= kbase + 63);
    }
    if (__all(full)) attn_step<KS, KSTR, QT, 0, QLDS>(o, m, l, qf, Ql, Kl, Vl, lane, kbase, lo, hi);
    else if (MODE == 1 && kbase + 63 <= twave_min) attn_step<KS, KSTR, QT, 2, QLDS>(o, m, l, qf, Ql, Kl, Vl, lane, kbase, lo, hi);
    else attn_step<KS, KSTR, QT, 1, QLDS>(o, m, l, qf, Ql, Kl, Vl, lane, kbase, lo, hi);
  }
}

template <int DQK, int QT, int MODE, bool QLDS>
DI void attn_loop(f32x4 (&o)[QT][4], float (&m)[QT], float (&l)[QT], const bf16x8 (&qf)[QT][DQK / 32], const LAS bf16_t* Ql, unsigned rem,
                  const bf16_t* __restrict__ Kg, int kstride, const bf16_t* __restrict__ Vtg, int vstride,
                  LAS bf16_t* Kl0, LAS bf16_t* Vl0, const int (&tq)[QT], const unsigned (&sel)[QT], int twave_min, int twave_max) {
  constexpr int KSTR = DQK + 8, CPR = DQK / 8, NKC = (64 * CPR + 511) / 512;
  constexpr int KBUF = 64 * KSTR, VBUF = 64 * VSTR;
  const int tid = otid();
  constexpr bool TWO = ATT_TWO_TILES(DQK, QT); constexpr int SL = TWO ? 2 : 1;
  u32x4 krA[NKC], vrA, krB[TWO ? NKC : 1], vrB;
#define ATT_GLOAD(jj, KR, VR) do { _Pragma("unroll") for (int c_ = 0; c_ < NKC; ++c_) { const int ch_ = tid + c_ * 512; if (ch_ < 64 * CPR) { const int row_ = ch_ / CPR, cc_ = ch_ - row_ * CPR; \
      KR[c_] = *(const u32x4*)(Kg + (size_t)((jj) * 64 + row_) * kstride + cc_ * 8); } } \
    { const int d_ = tid >> 3, cc_ = tid & 7; VR = *(const u32x4*)(Vtg + (size_t)d_ * vstride + (jj) * 64 + cc_ * 8); } } while (0)
#define ATT_LSTORE(slot, KR, VR) do { _Pragma("unroll") for (int c_ = 0; c_ < NKC; ++c_) { const int ch_ = tid + c_ * 512; if (ch_ < 64 * CPR) { const int row_ = ch_ / CPR, cc_ = ch_ - row_ * CPR; \
      *(LAS u32x4*)(Kl0 + (slot) * KBUF + row_ * KSTR + cc_ * 8) = KR[c_]; } } \
    { const int d_ = tid >> 3, cc_ = tid & 7; *(LAS u32x4*)(Vl0 + (slot) * VBUF + d_ * VSTR + cc_ * 8) = VR; } } while (0)
  if (rem == 0u) return;
  int j0 = __builtin_ctz(rem); rem &= rem - 1u;
  int j1 = -1; if (TWO && rem) { j1 = __builtin_ctz(rem); rem &= rem - 1u; }
  ATT_GLOAD(j0, krA, vrA); if (TWO && j1 >= 0) ATT_GLOAD(j1, krB, vrB);
  ATT_LSTORE(0, krA, vrA); if (TWO && j1 >= 0) ATT_LSTORE(1, krB, vrB);
  __syncthreads();
  int buf = 0;
  for (;;) {
    int n0 = -1, n1 = -1;
    if (rem) { n0 = __builtin_ctz(rem); rem &= rem - 1u; ATT_GLOAD(n0, krA, vrA); }
    if (TWO && rem) { n1 = __builtin_ctz(rem); rem &= rem - 1u; ATT_GLOAD(n1, krB, vrB); }
    attn_tile<DQK, QT, MODE, QLDS>(o, m, l, qf, Ql, Kl0 + (buf * SL) * KBUF, Vl0 + (buf * SL) * VBUF, j0, tq, sel, twave_min, twave_max);
    if (TWO && j1 >= 0) attn_tile<DQK, QT, MODE, QLDS>(o, m, l, qf, Ql, Kl0 + (buf * SL + 1) * KBUF, Vl0 + (buf * SL + 1) * VBUF, j1, tq, sel, twave_min, twave_max);
    if (n0 >= 0) ATT_LSTORE((buf ^ 1) * SL, krA, vrA);
    if (TWO && n1 >= 0) ATT_LSTORE((buf ^ 1) * SL + 1, krB, vrB);
    __syncthreads();
    if (n0 < 0) break;
    j0 = n0; j1 = n1; buf ^= 1;
  }
#undef ATT_GLOAD
#undef ATT_LSTORE
}


template <int MODE>
DI void attn_loop_pair(f32x4 (&oA)[1][4], float (&mA)[1], float (&lA)[1], const bf16x8 (&qA)[1][2], const int (&tqA)[1], const unsigned (&selA)[1], int tminA, int tmaxA,
                       f32x4 (&oB)[1][4], float (&mB)[1], float (&lB)[1], const bf16x8 (&qB)[1][2], const int (&tqB)[1], const unsigned (&selB)[1], int tminB, int tmaxB,
                       unsigned rem, const bf16_t* __restrict__ Kg, int kstride, const bf16_t* __restrict__ Vtg, int vstride, LAS bf16_t* Kl0, LAS bf16_t* Vl0) {
  constexpr int KSTR = 72, KBUF = 64 * KSTR, VBUF = 64 * VSTR;
  const int tid = otid();
  const int krow = tid >> 3, kcc = tid & 7;
  u32x4 kA, vA, kB, vB;
#define PR_GLOAD(jj, KR, VR) do { KR = *(const u32x4*)(Kg + (size_t)((jj) * 64 + krow) * kstride + kcc * 8); VR = *(const u32x4*)(Vtg + (size_t)krow * vstride + (jj) * 64 + kcc * 8); } while (0)
#define PR_LSTORE(slot, KR, VR) do { *(LAS u32x4*)(Kl0 + (slot) * KBUF + krow * KSTR + kcc * 8) = KR; *(LAS u32x4*)(Vl0 + (slot) * VBUF + krow * VSTR + kcc * 8) = VR; } while (0)
#define PR_TILE(slot, jj) do { \
    attn_tile<64, 1, MODE, false>(oA, mA, lA, qA, (const LAS bf16_t*)nullptr, Kl0 + (slot) * KBUF, Vl0 + (slot) * VBUF, (jj), tqA, selA, tminA, tmaxA); \
    attn_tile<64, 1, MODE, false>(oB, mB, lB, qB, (const LAS bf16_t*)nullptr, Kl0 + (slot) * KBUF, Vl0 + (slot) * VBUF, (jj), tqB, selB, tminB, tmaxB); } while (0)
  if (rem == 0u) return;
  int j0 = __builtin_ctz(rem); rem &= rem - 1u;
  int j1 = -1; if (rem) { j1 = __builtin_ctz(rem); rem &= rem - 1u; }
  PR_GLOAD(j0, kA, vA); if (j1 >= 0) PR_GLOAD(j1, kB, vB);
  PR_LSTORE(0, kA, vA); if (j1 >= 0) PR_LSTORE(1, kB, vB);
  __syncthreads();
  int buf = 0;
  for (;;) {
    int n0 = -1, n1 = -1;
    if (rem) { n0 = __builtin_ctz(rem); rem &= rem - 1u; PR_GLOAD(n0, kA, vA); }
    if (rem) { n1 = __builtin_ctz(rem); rem &= rem - 1u; PR_GLOAD(n1, kB, vB); }
    PR_TILE(buf * 2, j0);
    if (j1 >= 0) PR_TILE(buf * 2 + 1, j1);
    if (n0 >= 0) PR_LSTORE((buf ^ 1) * 2, kA, vA);
    if (n1 >= 0) PR_LSTORE((buf ^ 1) * 2 + 1, kB, vB);
    __syncthreads();
    if (n0 < 0) break;
    j0 = n0; j1 = n1; buf ^= 1;
  }
#undef PR_GLOAD
#undef PR_LSTORE
#undef PR_TILE
}

DI void mla_attn_phase(const bf16_t* __restrict__ Qb, const bf16_t* __restrict__ Kb, const bf16_t* __restrict__ Vt, bf16_t* YB, LAS unsigned char* lds) {
  constexpr int QT = 2, DQK = 96, KS = 3;
  LAS bf16_t* Kl = (LAS bf16_t*)lds; LAS bf16_t* Vl = (LAS bf16_t*)(lds + 4 * 64 * (DQK + 8) * 2);
  const int tid = otid(), lane = tid & 63, wv = __builtin_amdgcn_readfirstlane(tid >> 6), G = gridDim.x, c = blockIdx.x;
  const bool xl = (G & 7) == 0;
  const int nsl = xl ? (G >> 3) : G, xcd = c & 7, slot = xl ? (c >> 3) : c, nun = xl ? 64 : 512;
  for (int rnd = 0; rnd * nsl < nun; ++rnd) {
    const int v = (rnd & 1) ? (rnd + 1) * nsl - 1 - slot : rnd * nsl + slot;
    if (v >= nun) continue;
    const int qb = 7 - (xl ? (v >> 3) : (v >> 6)), bh = xl ? (xcd * 8 + (v & 7)) : (v & 63), b = bh >> 3, h = bh & 7;
    const int q0 = qb * 256 + wv * 32;
    bf16x8 qf[QT][KS];
#pragma unroll
    for (int qt = 0; qt < QT; ++qt)
#pragma unroll
      for (int ks = 0; ks < KS; ++ks)
        qf[qt][ks] = *(const bf16x8*)(Qb + (size_t)(b * SEQ + q0 + qt * 16 + (lane & 15)) * 768 + h * 96 + ks * 32 + (lane >> 4) * 8);
    f32x4 o[QT][4]; float m[QT], l[QT]; int tq[QT]; unsigned sel[QT];
#pragma unroll
    for (int qt = 0; qt < QT; ++qt) { m[qt] = -1e30f; l[qt] = 0.f; tq[qt] = q0 + qt * 16 + (lane & 15); sel[qt] = 0u;
#pragma unroll
      for (int dt = 0; dt < 4; ++dt) o[qt][dt] = (f32x4){0.f, 0.f, 0.f, 0.f}; }
    const int jhi = (qb * 256 + 255) >> 6;
    const unsigned rem = (2u << jhi) - 1u;
    attn_loop<DQK, QT, 0, false>(o, m, l, qf, (const LAS bf16_t*)nullptr, rem, Kb + (size_t)b * SEQ * 768 + h * 96, 768, Vt + (size_t)(b * 8 + h) * 64 * SEQ, SEQ, Kl, Vl, tq, sel, q0, q0 + 31);
#pragma unroll
    for (int qt = 0; qt < QT; ++qt) {
      const float inv = 1.f / fmaxf(l[qt], 1e-20f);
      bf16_t* dst = YB + (size_t)(b * SEQ + tq[qt]) * 1024 + 512 + h * 64 + (lane >> 4) * 4;
#pragma unroll
      for (int dt = 0; dt < 4; ++dt) { const f32x4 v = o[qt][dt] * inv; u32x2 w; w.x = cvt_pk_bf16(v[0], v[1]); w.y = cvt_pk_bf16(v[2], v[3]); *(u32x2*)(dst + dt * 16) = w; }
    }
  }
}
DI void nsa_cmp2_phase(const float* __restrict__ CH  , const float* __restrict__ cbias  , const float* __restrict__ w2  , bf16_t* KC, bf16_t* VTC, LAS float* wl) {
  const int lane = otid() & 63, wv = otid() >> 6;
  for (int i = otid(); i < 2 * 128 * 64; i += 512) wl[i] = w2[i];
  __syncthreads();
  for (int item = blockIdx.x * 8 + wv; item < 2 * 2048; item += gridDim.x * 8) {
    const int kind = item >> 11, row = item & 2047, bg = row >> 7, n = row & 127;
    const float* ch = CH + ((size_t)kind * 8 * 2048 + row) * 128;
    const LAS float* w = wl + kind * 128 * 64 + lane;
    float c0 = 0.f, c1 = 0.f;
#pragma unroll
    for (int q = 0; q < 16; ++q) { c0 += cbias[(kind * 16 + q) * 128 + lane]; c1 += cbias[(kind * 16 + q) * 128 + 64 + lane]; }
#pragma unroll
    for (int cc = 0; cc < 8; ++cc) { c0 += ch[(size_t)cc * 2048 * 128 + lane]; c1 += ch[(size_t)cc * 2048 * 128 + 64 + lane]; }
    c0 = siluf_(c0); c1 = siluf_(c1);
    float acc = 0.f;
#pragma unroll 8
    for (int h = 0; h < 64; ++h) acc += __shfl(c0, h) * w[h * 64];
#pragma unroll 8
    for (int h = 0; h < 64; ++h) acc += __shfl(c1, h) * w[(64 + h) * 64];
    if (n == 127) acc = 0.f;
    const bf16_t o = (bf16_t)(cvt_pk_bf16(acc, 0.f) & 0xffffu);
    if (kind == 0) KC[((size_t)bg * 128 + n) * 64 + lane] = o; else VTC[((size_t)bg * 64 + lane) * 128 + n] = o;
  }
}

#ifndef NSA_QT
#define NSA_QT 2
#endif
constexpr int NSA_TQ = 16 * NSA_QT;
constexpr bool NSA_QL = (NSA_QT == 2);
constexpr int NSA_SLOTS = ATT_TWO_TILES(64, NSA_QT) ? 4 : 2;
constexpr int N_IMP = 8 * NSA_TQ * 32 * 4, N_IMPF = NSA_TQ * 33 * 4;
constexpr int N_KL = NSA_SLOTS * 64 * 72 * 2, N_VL0 = NSA_SLOTS * 64 * VSTR * 2, N_VL = (N_KL + N_VL0 >= N_IMP + N_IMPF ? N_VL0 : ((N_IMP + N_IMPF - N_KL + 255) & ~255)), N_KC = 128 * 72 * 2, N_VC = 64 * 136 * 2, N_QL = NSA_QL ? 8 * NSA_QT * 2 * 64 * 16 : 0;
constexpr int O_KL = 0, O_VL = O_KL + N_KL, O_KC = O_VL + N_VL, O_VC = O_KC + N_KC, O_SEL = O_VC + N_VC, O_QL = O_SEL + 256, O_END = O_QL + N_QL;
constexpr int O_IMP = O_KL, O_IMPF = O_IMP + N_IMP;
static_assert(N_IMP + N_IMPF <= N_KL + N_VL, "NSA LDS alias");
static_assert(O_END <= LDS_BYTES - 256, "NSA LDS map");
DI void nsa_attn_phase(unsigned char* ws, LAS unsigned char* lds) {
#define Qb  ((const bf16_t*)(ws + WS_QB))
#define KC  ((const bf16_t*)(ws + WS_KC))
#define VTC ((const bf16_t*)(ws + WS_VTC))
#define KS  ((const bf16_t*)(ws + WS_KS))
#define VTS ((const bf16_t*)(ws + WS_VTS))
#define KW  ((const bf16_t*)(ws + WS_KW))
#define VTW ((const bf16_t*)(ws + WS_VTW))
#define GT  ((const float*)(ws + WS_GT))
#define YB  ((bf16_t*)(ws + WS_YB))
#define YF  ((float*)(ws + WS_YF))
  constexpr int QT = NSA_QT, TQ = NSA_TQ, NTB = SEQ / TQ;
  LAS bf16_t* Kl = (LAS bf16_t*)(lds + O_KL); LAS bf16_t* Vl = (LAS bf16_t*)(lds + O_VL);
  LAS bf16_t* Kc = (LAS bf16_t*)(lds + O_KC); LAS bf16_t* Vc = (LAS bf16_t*)(lds + O_VC);
  LAS float* IMP = (LAS float*)(lds + O_IMP); LAS float* IMPF = (LAS float*)(lds + O_IMPF); LAS unsigned* SEL = (LAS unsigned*)(lds + O_SEL);
  const int tid = otid(), lane = tid & 63, wv = __builtin_amdgcn_readfirstlane(tid >> 6), G = gridDim.x, c = blockIdx.x;
  LAS bf16_t* Ql = (LAS bf16_t*)(lds + O_QL) + (NSA_QL ? wv * (QT * 2 * 64 * 8) : 0);
  const int r = lane & 15, g4 = lane >> 4;
  const bool xl = (G & 15) == 0;
  const int nsl = xl ? (G >> 4) : G, slot = xl ? (c >> 4) : c, nun = xl ? NTB : NTB * 16;
  int last_bg = -1;
  for (int rnd = 0; rnd * nsl < nun; ++rnd) {
    const int v = (rnd & 1) ? (rnd + 1) * nsl - 1 - slot : rnd * nsl + slot;
    if (v >= nun) continue;
    const int tb = (NTB - 1) - (xl ? v : (v >> 4)), bg = xl ? ((c & 7) + 8 * ((c >> 3) & 1)) : (v & 15), b = bg >> 1, g = bg & 1;
    const int t0 = tb * TQ, head = g * 8 + wv;
    if (bg != last_bg) {
    for (int ch = tid; ch < 128 * 8; ch += 512) { const int row = ch >> 3, cc = ch & 7; *(LAS u32x4*)(Kc + row * 72 + cc * 8) = *(const u32x4*)(KC + ((size_t)bg * 128 + row) * 64 + cc * 8); }
    for (int ch = tid; ch < 64 * 16; ch += 512) { const int row = ch >> 4, cc = ch & 15; *(LAS u32x4*)(Vc + row * 136 + cc * 8) = *(const u32x4*)(VTC + ((size_t)bg * 64 + row) * 128 + cc * 8); }
    last_bg = bg; }
    if (tid == 0) SEL[32] = 0u;
    bf16x8 qf[QT][2]; int tq[QT];
    constexpr bool OFR = (NSA_QT == 1);
    f32x4 ofin[QT][4];
#pragma unroll
    for (int qt = 0; qt < QT; ++qt) {
      tq[qt] = t0 + qt * 16 + r;
      const size_t tok = (size_t)b * SEQ + tq[qt];
#pragma unroll
      for (int ks = 0; ks < 2; ++ks) { qf[qt][ks] = *(const bf16x8*)(Qb + tok * 1024 + head * 64 + ks * 32 + g4 * 8);
        if (NSA_QL) *(LAS bf16x8*)(Ql + ((qt * 2 + ks) * 64 + lane) * 8) = qf[qt][ks]; }
    }
    __syncthreads();
#ifndef NSA_REP_C
#define NSA_REP_C 1
#define NSA_REP_S 1
#define NSA_REP_W 1
#endif
    for (int repc = 0; repc < NSA_REP_C; ++repc) {
    {
      const int tlc = otid(); const int r = tlc & 15, g4 = (tlc >> 4) & 3, lane = tlc & 63;
#pragma unroll
      for (int qt = 0; qt < QT; ++qt) {
        f32x4 oc[4];
#pragma unroll
        for (int dt = 0; dt < 4; ++dt) oc[dt] = (f32x4){0.f, 0.f, 0.f, 0.f};
        f32x4 sc[8];
#pragma unroll
        for (int kt = 0; kt < 8; ++kt) {
          sc[kt] = (f32x4){0.f, 0.f, 0.f, 0.f};
#pragma unroll
          for (int ks = 0; ks < 2; ++ks) {
            const bf16x8 kf = *(const LAS bf16x8*)(Kc + (kt * 16 + r) * 72 + ks * 32 + g4 * 8);
            const bf16x8 qv = NSA_QL ? *(const LAS bf16x8*)(Ql + ((qt * 2 + ks) * 64 + lane) * 8) : qf[qt][ks];
            sc[kt] = MFMA16(kf, qv, sc[kt]);
          }
        }
        float mx = -1e30f;
#pragma unroll
        for (int kt = 0; kt < 8; ++kt)
#pragma unroll
          for (int i = 0; i < 4; ++i) {
            const int n = kt * 16 + g4 * 4 + i;
            const bool valid = (16 * n + 31 <= tq[qt]) && (n < 127);
            const float sv = valid ? sc[kt][i] : -1e30f;
            sc[kt][i] = sv; mx = fmaxf(mx, sv);
          }
        mx = fmaxf(mx, __shfl_xor(mx, 16)); mx = fmaxf(mx, __shfl_xor(mx, 32));
        float rsum = 0.f;
#pragma unroll
        for (int kt = 0; kt < 8; ++kt)
#pragma unroll
          for (int i = 0; i < 4; ++i) { const float sv = sc[kt][i]; const float pv = (sv > -1e29f) ? fast_exp2(sv - mx) : 0.f; sc[kt][i] = pv; rsum += pv; }
        rsum += __shfl_xor(rsum, 16); rsum += __shfl_xor(rsum, 32);
        const float inv = 1.f / fmaxf(rsum, 1e-20f);
        float prevb = 0.f;
#pragma unroll
        for (int kt = 0; kt < 8; ++kt) {
          sc[kt] = sc[kt] * inv;
          const float a = (sc[kt][0] + sc[kt][1]) + (sc[kt][2] + 0.5f * sc[kt][3]);
          const float bcur = 0.5f * sc[kt][3];
          const float up = __shfl(bcur, (lane + 48) & 63);
          const float wrap = __shfl(prevb, (lane + 48) & 63);
          IMP[(wv * TQ + qt * 16 + r) * 32 + kt * 4 + g4] = a + (g4 > 0 ? up : wrap);
          prevb = bcur;
        }
#pragma unroll
        for (int k4 = 0; k4 < 4; ++k4) {
          u32x4 w; w.x = cvt_pk_v(sc[2 * k4][0], sc[2 * k4][1]); w.y = cvt_pk_v(sc[2 * k4][2], sc[2 * k4][3]);
          w.z = cvt_pk_v(sc[2 * k4 + 1][0], sc[2 * k4 + 1][1]); w.w = cvt_pk_v(sc[2 * k4 + 1][2], sc[2 * k4 + 1][3]);
          const bf16x8 pb = __builtin_bit_cast(bf16x8, w);
#pragma unroll
          for (int dt = 0; dt < 4; ++dt) {
            const LAS bf16_t* vp = Vc + (dt * 16 + r) * 136 + k4 * 32 + 4 * g4;
            const u32x2 lo2 = *(const LAS u32x2*)vp, hi2 = *(const LAS u32x2*)(vp + 16);
            u32x4 vv; vv.x = lo2.x; vv.y = lo2.y; vv.z = hi2.x; vv.w = hi2.y;
            oc[dt] = MFMA16(__builtin_bit_cast(bf16x8, vv), pb, oc[dt]);
          }
        }
        { const float g0 = GT[((size_t)b * SEQ + tq[qt]) * 48 + head * 3 + 0];
          float* yf = YF + ((size_t)b * SEQ + tq[qt]) * 1024 + head * 64 + g4 * 4;
#pragma unroll
          for (int dt = 0; dt < 4; ++dt) { if (OFR) ofin[qt][dt] = oc[dt] * g0; else *(f32x4*)(yf + dt * 16) = oc[dt] * g0; } }
        asm volatile("" ::: "memory");
      }
    }
    __syncthreads();
    for (int idx = tid; idx < TQ * 32; idx += 512) {
      const int q = idx >> 5, j = idx & 31; float sgm = 0.f;
#pragma unroll
      for (int h = 0; h < 8; ++h) sgm += IMP[(h * TQ + q) * 32 + j];
      IMPF[q * 33 + j] = sgm;
    }
    __syncthreads();
    for (int idx = tid; idx < TQ * 32; idx += 512) {
      const int q = idx >> 5, j = idx & 31, t = t0 + q, cur = t >> 6;
      const bool forced = (j == 0) || (j == cur) || (j == cur - 1), causal = (j <= cur), cand = causal && !forced;
      const float my = IMPF[q * 33 + j];
      int rank = 0;
#pragma unroll
      for (int jj = 0; jj < 32; ++jj) {
        const float v = IMPF[q * 33 + jj];
        const bool cj = (jj <= cur) && !((jj == 0) || (jj == cur) || (jj == cur - 1));
        rank += (cj && (v > my || (v == my && jj < j))) ? 1 : 0;
      }
      const bool sbit = causal && (forced || cur < 8 || (cand && rank < 5));
      const unsigned long long bal = __ballot(sbit);
      if ((lane & 31) == 0) { const unsigned sl = (lane == 0) ? (unsigned)bal : (unsigned)(bal >> 32); SEL[q] = sl; __hip_atomic_fetch_or(&SEL[32], sl, __ATOMIC_RELAXED, __HIP_MEMORY_SCOPE_WORKGROUP); }
    }
    __syncthreads();
    }
    unsigned sel[QT];
#pragma unroll
    for (int qt = 0; qt < QT; ++qt) sel[qt] = SEL[qt * 16 + r];
    const unsigned uni = (unsigned)__builtin_amdgcn_readfirstlane((int)SEL[32]);
    {
      f32x4 o[QT][4]; float m[QT], l[QT];
#pragma unroll
      for (int qt = 0; qt < QT; ++qt) { m[qt] = -1e30f; l[qt] = 0.f;
#pragma unroll
        for (int dt = 0; dt < 4; ++dt) o[qt][dt] = (f32x4){0.f, 0.f, 0.f, 0.f}; }
      for (int reps = 0; reps < NSA_REP_S; ++reps) {
#pragma unroll
      for (int qt = 0; qt < QT; ++qt) { m[qt] = -1e30f; l[qt] = 0.f;
#pragma unroll
        for (int dt = 0; dt < 4; ++dt) o[qt][dt] = (f32x4){0.f, 0.f, 0.f, 0.f}; }
      attn_loop<64, QT, 1, NSA_QL>(o, m, l, qf, Ql, uni, KS + (size_t)bg * SEQ * 64, 64, VTS + (size_t)bg * 64 * SEQ, SEQ, Kl, Vl, tq, sel, t0, t0 + TQ - 1); }
#pragma unroll
      for (int qt = 0; qt < QT; ++qt) { const float sc1 = GT[((size_t)b * SEQ + tq[qt]) * 48 + head * 3 + 1] / fmaxf(l[qt], 1e-20f);
        float* yf = YF + ((size_t)b * SEQ + tq[qt]) * 1024 + head * 64 + g4 * 4;
#pragma unroll
        for (int dt = 0; dt < 4; ++dt) { if (OFR) ofin[qt][dt] = ofin[qt][dt] + o[qt][dt] * sc1; else *(f32x4*)(yf + dt * 16) = *(const f32x4*)(yf + dt * 16) + o[qt][dt] * sc1; } }
    }
    {
      f32x4 o[QT][4]; float m[QT], l[QT];
#pragma unroll
      for (int qt = 0; qt < QT; ++qt) { m[qt] = -1e30f; l[qt] = 0.f;
#pragma unroll
        for (int dt = 0; dt < 4; ++dt) o[qt][dt] = (f32x4){0.f, 0.f, 0.f, 0.f}; }
      const int jlo = (t0 - 511 > 0 ? t0 - 511 : 0) >> 6, jhi = (t0 + TQ - 1) >> 6;
      const unsigned remw = ((2u << jhi) - 1u) & ~((1u << jlo) - 1u);
      for (int repw = 0; repw < NSA_REP_W; ++repw) {
#pragma unroll
      for (int qt = 0; qt < QT; ++qt) { m[qt] = -1e30f; l[qt] = 0.f;
#pragma unroll
        for (int dt = 0; dt < 4; ++dt) o[qt][dt] = (f32x4){0.f, 0.f, 0.f, 0.f}; }
      attn_loop<64, QT, 2, NSA_QL>(o, m, l, qf, Ql, remw, KW + (size_t)bg * SEQ * 64, 64, VTW + (size_t)bg * 64 * SEQ, SEQ, Kl, Vl, tq, sel, t0, t0 + TQ - 1); }
#pragma unroll
      for (int qt = 0; qt < QT; ++qt) { const float sc2 = GT[((size_t)b * SEQ + tq[qt]) * 48 + head * 3 + 2] / fmaxf(l[qt], 1e-20f);
        const float* yf = YF + ((size_t)b * SEQ + tq[qt]) * 1024 + head * 64 + g4 * 4;
        bf16_t* dst = YB + ((size_t)b * SEQ + tq[qt]) * 1024 + head * 64 + g4 * 4;
#pragma unroll
        for (int dt = 0; dt < 4; ++dt) { const f32x4 v = (OFR ? ofin[qt][dt] : *(const f32x4*)(yf + dt * 16)) + o[qt][dt] * sc2; u32x2 w; w.x = cvt_pk_bf16(v[0], v[1]); w.y = cvt_pk_bf16(v[2], v[3]); *(u32x2*)(dst + dt * 16) = w; } }
    }
    __syncthreads();
  }
}
#undef Qb
#undef KC
#undef VTC
#undef KS
#undef VTS
#undef KW
#undef VTW
#undef GT
#undef YB
#undef YF

constexpr int P_KL = 0, P_VL = P_KL + 4 * 64 * 72 * 2, P_KC = P_VL + 4 * 64 * VSTR * 2, P_VC = P_KC + 128 * 72 * 2, P_SEL = P_VC + 64 * 136 * 2, P_IMPF = P_SEL + 256, P_END = P_IMPF + 32 * 33 * 4;
static_assert(P_END <= LDS_BYTES - 256, "NSA pair LDS map");
DI void nsa_attn_phase2(unsigned char* ws, LAS unsigned char* lds) {
#define Qb  ((const bf16_t*)(ws + WS_QB))
#define KC  ((const bf16_t*)(ws + WS_KC))
#define VTC ((const bf16_t*)(ws + WS_VTC))
#define KS  ((const bf16_t*)(ws + WS_KS))
#define VTS ((const bf16_t*)(ws + WS_VTS))
#define KW  ((const bf16_t*)(ws + WS_KW))
#define VTW ((const bf16_t*)(ws + WS_VTW))
#define GT  ((const float*)(ws + WS_GT))
#define YB  ((bf16_t*)(ws + WS_YB))
#define YF  ((float*)(ws + WS_YF))
  constexpr int TQ = 32, NTB = SEQ / TQ;
  LAS bf16_t* Kl = (LAS bf16_t*)(lds + P_KL); LAS bf16_t* Vl = (LAS bf16_t*)(lds + P_VL);
  LAS bf16_t* Kc = (LAS bf16_t*)(lds + P_KC); LAS bf16_t* Vc = (LAS bf16_t*)(lds + P_VC);
  LAS float* IMPF = (LAS float*)(lds + P_IMPF); LAS unsigned* SEL = (LAS unsigned*)(lds + P_SEL);
  const int tid = otid(), lane = tid & 63, wv = __builtin_amdgcn_readfirstlane(tid >> 6), G = gridDim.x, c = blockIdx.x;
  const int r = lane & 15, g4 = lane >> 4, tokl = r >> 3, hl = r & 7;
  const bool xl = (G & 15) == 0;
  const int nsl = xl ? (G >> 4) : G, slot = xl ? (c >> 4) : c, nun = xl ? NTB : NTB * 16;
  int last_bg = -1;
  for (int rnd = 0; rnd * nsl < nun; ++rnd) {
    const int v = (rnd & 1) ? (rnd + 1) * nsl - 1 - slot : rnd * nsl + slot;
    if (v >= nun) continue;
    const int tb = (NTB - 1) - (xl ? v : (v >> 4)), bg = xl ? (2 * (c & 7) + ((c >> 3) & 1)) : (v & 15), b = bg >> 1, g = bg & 1;
    const int t0 = tb * TQ, head = g * 8 + hl;
    if (bg != last_bg) {
      for (int ch = tid; ch < 128 * 8; ch += 512) { const int row = ch >> 3, cc = ch & 7; *(LAS u32x4*)(Kc + row * 72 + cc * 8) = *(const u32x4*)(KC + ((size_t)bg * 128 + row) * 64 + cc * 8); }
      for (int ch = tid; ch < 64 * 16; ch += 512) { const int row = ch >> 4, cc = ch & 15; *(LAS u32x4*)(Vc + row * 136 + cc * 8) = *(const u32x4*)(VTC + ((size_t)bg * 64 + row) * 128 + cc * 8); }
      last_bg = bg; }
    if (tid == 0) SEL[32] = 0u;
    bf16x8 qf[2][1][2]; int tq[2][1];
#pragma unroll
    for (int s = 0; s < 2; ++s) {
      tq[s][0] = t0 + 4 * wv + 2 * s + tokl;
      const size_t tok = (size_t)b * SEQ + tq[s][0];
#pragma unroll
      for (int ks = 0; ks < 2; ++ks) qf[s][0][ks] = *(const bf16x8*)(Qb + tok * 1024 + head * 64 + ks * 32 + g4 * 8);
    }
    __syncthreads();
    {
    const int tlc = otid(); const int r = tlc & 15, g4 = (tlc >> 4) & 3, lane = tlc & 63, tokl = r >> 3, hl = r & 7;
#pragma unroll
    for (int s = 0; s < 2; ++s) {
      f32x4 oc[4];
#pragma unroll
      for (int dt = 0; dt < 4; ++dt) oc[dt] = (f32x4){0.f, 0.f, 0.f, 0.f};
      f32x4 sc[8];
#pragma unroll
      for (int kt = 0; kt < 8; ++kt) {
        sc[kt] = (f32x4){0.f, 0.f, 0.f, 0.f};
#pragma unroll
        for (int ks = 0; ks < 2; ++ks) {
          const bf16x8 kf = *(const LAS bf16x8*)(Kc + (kt * 16 + r) * 72 + ks * 32 + g4 * 8);
          sc[kt] = MFMA16(kf, qf[s][0][ks], sc[kt]);
        }
      }
      float mx = -1e30f;
#pragma unroll
      for (int kt = 0; kt < 8; ++kt)
#pragma unroll
        for (int i = 0; i < 4; ++i) {
          const int n = kt * 16 + g4 * 4 + i;
          const bool valid = (16 * n + 31 <= tq[s][0]) && (n < 127);
          const float sv = valid ? sc[kt][i] : -1e30f;
          sc[kt][i] = sv; mx = fmaxf(mx, sv);
        }
      mx = fmaxf(mx, __shfl_xor(mx, 16)); mx = fmaxf(mx, __shfl_xor(mx, 32));
      float rsum = 0.f;
#pragma unroll
      for (int kt = 0; kt < 8; ++kt)
#pragma unroll
        for (int i = 0; i < 4; ++i) { const float sv = sc[kt][i]; const float pv = (sv > -1e29f) ? fast_exp2(sv - mx) : 0.f; sc[kt][i] = pv; rsum += pv; }
      rsum += __shfl_xor(rsum, 16); rsum += __shfl_xor(rsum, 32);
      const float inv = 1.f / fmaxf(rsum, 1e-20f);
      float prevb = 0.f;
#pragma unroll
      for (int kt = 0; kt < 8; ++kt) {
        sc[kt] = sc[kt] * inv;
        const float a = (sc[kt][0] + sc[kt][1]) + (sc[kt][2] + 0.5f * sc[kt][3]);
        const float bcur = 0.5f * sc[kt][3];
        const float up = __shfl(bcur, (lane + 48) & 63);
        const float wrap = __shfl(prevb, (lane + 48) & 63);
        float impv = a + (g4 > 0 ? up : wrap);
        impv += __shfl_xor(impv, 1); impv += __shfl_xor(impv, 2); impv += __shfl_xor(impv, 4);
        if (hl == 0) IMPF[(4 * wv + 2 * s + tokl) * 33 + kt * 4 + g4] = impv;
        prevb = bcur;
      }
#pragma unroll
      for (int k4 = 0; k4 < 4; ++k4) {
        u32x4 w; w.x = cvt_pk_v(sc[2 * k4][0], sc[2 * k4][1]); w.y = cvt_pk_v(sc[2 * k4][2], sc[2 * k4][3]);
        w.z = cvt_pk_v(sc[2 * k4 + 1][0], sc[2 * k4 + 1][1]); w.w = cvt_pk_v(sc[2 * k4 + 1][2], sc[2 * k4 + 1][3]);
        const bf16x8 pb = __builtin_bit_cast(bf16x8, w);
#pragma unroll
        for (int dt = 0; dt < 4; ++dt) {
          const LAS bf16_t* vp = Vc + (dt * 16 + r) * 136 + k4 * 32 + 4 * g4;
          const u32x2 lo2 = *(const LAS u32x2*)vp, hi2 = *(const LAS u32x2*)(vp + 16);
          u32x4 vv; vv.x = lo2.x; vv.y = lo2.y; vv.z = hi2.x; vv.w = hi2.y;
          oc[dt] = MFMA16(__builtin_bit_cast(bf16x8, vv), pb, oc[dt]);
        }
      }
      { const float g0 = GT[((size_t)b * SEQ + tq[s][0]) * 48 + head * 3 + 0];
        float* yf = YF + ((size_t)b * SEQ + tq[s][0]) * 1024 + head * 64 + g4 * 4;
#pragma unroll
        for (int dt = 0; dt < 4; ++dt) *(f32x4*)(yf + dt * 16) = oc[dt] * g0; }
      asm volatile("" ::: "memory");
    }
    }
    __syncthreads();
    for (int idx = tid; idx < TQ * 32; idx += 512) {
      const int q = idx >> 5, j = idx & 31, t = t0 + q, cur = t >> 6;
      const bool forced = (j == 0) || (j == cur) || (j == cur - 1), causal = (j <= cur), cand = causal && !forced;
      const float my = IMPF[q * 33 + j];
      int rank = 0;
#pragma unroll
      for (int jj = 0; jj < 32; ++jj) {
        const float vv = IMPF[q * 33 + jj];
        const bool cj = (jj <= cur) && !((jj == 0) || (jj == cur) || (jj == cur - 1));
        rank += (cj && (vv > my || (vv == my && jj < j))) ? 1 : 0;
      }
      const bool sbit = causal && (forced || cur < 8 || (cand && rank < 5));
      const unsigned long long bal = __ballot(sbit);
      if ((lane & 31) == 0) { const unsigned sl = (lane == 0) ? (unsigned)bal : (unsigned)(bal >> 32); SEL[q] = sl; __hip_atomic_fetch_or(&SEL[32], sl, __ATOMIC_RELAXED, __HIP_MEMORY_SCOPE_WORKGROUP); }
    }
    __syncthreads();
    unsigned sel[2][1];
#pragma unroll
    for (int s = 0; s < 2; ++s) sel[s][0] = SEL[4 * wv + 2 * s + tokl];
    const unsigned uni = (unsigned)__builtin_amdgcn_readfirstlane((int)SEL[32]);
    const int tmA = t0 + 4 * wv, tmB = tmA + 2;
    {
      f32x4 oA[1][4], oB[1][4]; float mA[1] = {-1e30f}, lA[1] = {0.f}, mB[1] = {-1e30f}, lB[1] = {0.f};
#pragma unroll
      for (int dt = 0; dt < 4; ++dt) { oA[0][dt] = (f32x4){0.f, 0.f, 0.f, 0.f}; oB[0][dt] = (f32x4){0.f, 0.f, 0.f, 0.f}; }
      attn_loop_pair<1>(oA, mA, lA, qf[0], tq[0], sel[0], tmA, tmA + 1, oB, mB, lB, qf[1], tq[1], sel[1], tmB, tmB + 1,
                        uni, KS + (size_t)bg * SEQ * 64, 64, VTS + (size_t)bg * 64 * SEQ, SEQ, Kl, Vl);
      const float sA = GT[((size_t)b * SEQ + tq[0][0]) * 48 + head * 3 + 1] / fmaxf(lA[0], 1e-20f), sB = GT[((size_t)b * SEQ + tq[1][0]) * 48 + head * 3 + 1] / fmaxf(lB[0], 1e-20f);
      float* yfA = YF + ((size_t)b * SEQ + tq[0][0]) * 1024 + head * 64 + g4 * 4; float* yfB = YF + ((size_t)b * SEQ + tq[1][0]) * 1024 + head * 64 + g4 * 4;
#pragma unroll
      for (int dt = 0; dt < 4; ++dt) { *(f32x4*)(yfA + dt * 16) = *(const f32x4*)(yfA + dt * 16) + oA[0][dt] * sA; *(f32x4*)(yfB + dt * 16) = *(const f32x4*)(yfB + dt * 16) + oB[0][dt] * sB; }
    }
    {
      f32x4 oA[1][4], oB[1][4]; float mA[1] = {-1e30f}, lA[1] = {0.f}, mB[1] = {-1e30f}, lB[1] = {0.f};
#pragma unroll
      for (int dt = 0; dt < 4; ++dt) { oA[0][dt] = (f32x4){0.f, 0.f, 0.f, 0.f}; oB[0][dt] = (f32x4){0.f, 0.f, 0.f, 0.f}; }
      const int jlo = (t0 - 511 > 0 ? t0 - 511 : 0) >> 6, jhi = (t0 + TQ - 1) >> 6;
      const unsigned remw = ((2u << jhi) - 1u) & ~((1u << jlo) - 1u);
      attn_loop_pair<2>(oA, mA, lA, qf[0], tq[0], sel[0], tmA, tmA + 1, oB, mB, lB, qf[1], tq[1], sel[1], tmB, tmB + 1,
                        remw, KW + (size_t)bg * SEQ * 64, 64, VTW + (size_t)bg * 64 * SEQ, SEQ, Kl, Vl);
      const float sA = GT[((size_t)b * SEQ + tq[0][0]) * 48 + head * 3 + 2] / fmaxf(lA[0], 1e-20f), sB = GT[((size_t)b * SEQ + tq[1][0]) * 48 + head * 3 + 2] / fmaxf(lB[0], 1e-20f);
      const float* yfA = YF + ((size_t)b * SEQ + tq[0][0]) * 1024 + head * 64 + g4 * 4; const float* yfB = YF + ((size_t)b * SEQ + tq[1][0]) * 1024 + head * 64 + g4 * 4;
      bf16_t* dA = YB + ((size_t)b * SEQ + tq[0][0]) * 1024 + head * 64 + g4 * 4; bf16_t* dB = YB + ((size_t)b * SEQ + tq[1][0]) * 1024 + head * 64 + g4 * 4;
#pragma unroll
      for (int dt = 0; dt < 4; ++dt) {
        const f32x4 va = *(const f32x4*)(yfA + dt * 16) + oA[0][dt] * sA, vb = *(const f32x4*)(yfB + dt * 16) + oB[0][dt] * sB;
        u32x2 wa; wa.x = cvt_pk_bf16(va[0], va[1]); wa.y = cvt_pk_bf16(va[2], va[3]); *(u32x2*)(dA + dt * 16) = wa;
        u32x2 wb; wb.x = cvt_pk_bf16(vb[0], vb[1]); wb.y = cvt_pk_bf16(vb[2], vb[3]); *(u32x2*)(dB + dt * 16) = wb;
      }
    }
    __syncthreads();
  }
#undef Qb
#undef KC
#undef VTC
#undef KS
#undef VTS
#undef KW
#undef VTW
#undef GT
#undef YB
#undef YF
}

#define XB_TMO      128
#define XB_XCNT(j)  (256  + 64 * (j))
#define XB_XSUB(j)  (1280 + 64 * (j))
#define XB_XGEN(j)  (2304 + 64 * (j))
#define XB_TOP      3328
#define XB_TOPGEN   3392
#define XB_SPIN_CAP (1u << 22)
DI unsigned xb_ld(unsigned* p)              { return __hip_atomic_load(p, __ATOMIC_RELAXED, __HIP_MEMORY_SCOPE_AGENT); }
DI unsigned xb_add(unsigned* p, unsigned v) { return __hip_atomic_fetch_add(p, v, __ATOMIC_RELAXED, __HIP_MEMORY_SCOPE_AGENT); }
DI unsigned xb_xcc_id() { return (unsigned)__builtin_amdgcn_s_getreg((3 << 11) | 20) & 0xFu; }
#define XB_SPIN(cond, bar) do { unsigned _sp = 0; while (cond) { __builtin_amdgcn_s_sleep(1); \
    if ((++_sp & 255u) == 0u) { if (xb_ld(&(bar)[XB_TMO])) break; if (_sp > XB_SPIN_CAP) { atomicAdd(&(bar)[XB_TMO], 1u); break; } } } } while (0)
DI void xcd_barrier_complete(unsigned* bar, unsigned x, unsigned& nloc, unsigned& nx) {
    const unsigned G = gridDim.x * gridDim.y * gridDim.z;
    unsigned sum, cnt, mine, sp = 0u;
    for (;;) {
        sum = 0u; cnt = 0u; mine = 0u;
#pragma unroll
        for (unsigned j = 0; j < 16; ++j) { const unsigned c = xb_ld(&bar[XB_XCNT(j)]); sum += c; cnt += (c > 0u) ? 1u : 0u; mine = (j == x) ? c : mine; }
        if (sum == G) break;
        __builtin_amdgcn_s_sleep(1);
        if ((++sp & 255u) == 0u) { if (xb_ld(&bar[XB_TMO])) break; if (sp > XB_SPIN_CAP) { atomicAdd(&bar[XB_TMO], 1u); break; } }
    }
    nloc = mine > 0u ? mine : 1u; nx = cnt > 0u ? cnt : 1u;
}
DI void xcd_barrier(unsigned* bar, volatile LAS unsigned* st) {
    asm volatile("s_waitcnt vmcnt(0)" ::: "memory");
    __syncthreads();
    if (threadIdx.x == 0) {
        const unsigned x = xb_xcc_id();
        __builtin_amdgcn_s_waitcnt(0);
        unsigned nloc = st[0], nx = st[1];
        if (nloc == 0u) { xcd_barrier_complete(bar, x, nloc, nx); st[0] = nloc; st[1] = nx; }
        const unsigned old = xb_add(&bar[XB_XSUB(x)], 1u);
        const unsigned gen = old / nloc;
        if (old + 1u == (gen + 1u) * nloc) {
            __builtin_amdgcn_fence(__ATOMIC_RELEASE, "agent");
            asm volatile("s_waitcnt vmcnt(0)" ::: "memory");
            const unsigned og = xb_add(&bar[XB_TOP], 1u);
            const unsigned tg = og / nx;
            if (og + 1u == (tg + 1u) * nx) xb_add(&bar[XB_TOPGEN], 1u);
            else XB_SPIN(xb_ld(&bar[XB_TOPGEN]) == tg, bar);
            __builtin_amdgcn_fence(__ATOMIC_ACQUIRE, "agent");
            xb_add(&bar[XB_XGEN(x)], 1u);
            asm volatile("s_waitcnt vmcnt(0)" ::: "memory");
        } else {
            XB_SPIN(xb_ld(&bar[XB_XGEN(x)]) == gen, bar);
            __builtin_amdgcn_fence(__ATOMIC_ACQUIRE, "agent");
            asm volatile("s_waitcnt vmcnt(0)" ::: "memory");
        }
    }
    __syncthreads();
}

template <class Epi> DI void run_gemm(LAS unsigned char* lds, const bf16_t* A, int lda, const bf16_t* Bt, int M, int N, int K, const Epi& E, int crot = 0, int ldb = 0) {
  if (ldb == 0) ldb = K;
  asm volatile("" : "+s"(K), "+s"(lda), "+s"(N), "+s"(M), "+s"(ldb));
  pg8::Gemm g{A, Bt, M, N, K, lda, ldb};
  pg8::StaticOrder S; S.init(M, N, (int)gridDim.x, (int)((blockIdx.x + gridDim.x - crot) % gridDim.x));
  pg8::gemm_phase<Epi, pg8::StaticOrder, true, true>(lds, g, S, E);
}

#ifndef PHMASK
#define PHMASK 0xffffffffu
#endif
#define PH(k) ((PHMASK >> (k)) & 1u)
#ifndef DBLMASK
#define DBLMASK 0u
#endif
#define REP(k) for (int r_ = 0; r_ < 1 + (int)((DBLMASK >> (k)) & 1u); ++r_)
#ifndef EXTRA_SYNCS
#define EXTRA_SYNCS 0
#endif
typedef const __attribute__((address_space(4))) Params* KP;
DI KP kparams() { KP kp = (KP)__builtin_amdgcn_kernarg_segment_ptr(); asm volatile("" : "+s"(kp)); return kp; }
#define WSP(type, off) ((type*)(kparams()->ws + (off)))
#define MODL(l) (WSP(float, WS_MOD) + (size_t)(l) * NB * NMOD)
#define XB_ST ((volatile LAS unsigned*)(lds + LDS_BYTES - 64))
#ifndef USE_CG_SYNC
#define GSYNC() xcd_barrier(WSP(unsigned, WS_BAR), XB_ST)
#else
#define GSYNC() grid.sync()
#endif
__global__ void __launch_bounds__(512, 2) mega(Params p_unused) {
  extern __shared__ __attribute__((aligned(16))) unsigned char lds_raw[];
  LAS unsigned char* lds = (LAS unsigned char*)lds_raw;
  cg::grid_group grid = cg::this_grid();
  { unsigned* bar0 = WSP(unsigned, WS_BAR);
    if (threadIdx.x == 0) { XB_ST[0] = 0u; XB_ST[1] = 0u; (void)xb_add(&bar0[XB_XCNT(xb_xcc_id())], 1u); } }
  __syncthreads();

  REP(0) if (PH(0)) {
    LAS float* tile = (LAS float*)lds;
    int rot = 0;
#ifndef PREP_REP_T
#define PREP_REP_T 1
#endif
    for (int rt_ = 0; rt_ < PREP_REP_T; ++rt_) {
    for (int i = 0; i < 8; ++i) {
      prep_transpose<1, 256, true>(kparams()->ff_w13 + (size_t)i * D * 2 * DFF, D, 2 * DFF, WSP(bf16_t, WS_WT13) + (size_t)i * 2 * DFF * D, 2 * DFF, tile, rot);
      prep_transpose<0, 256, true>(kparams()->ff_w2 + (size_t)i * DFF * D, DFF, D, WSP(bf16_t, WS_WT2) + (size_t)i * D * DFF, D, tile, rot);
    }
    for (int m = 0; m < 2; ++m) {
      prep_transpose<0, 256, true>(kparams()->hy_w_in + (size_t)m * D * HY_IN, D, HY_IN, WSP(bf16_t, WS_WTHI) + (size_t)m * 2048 * D, 2048, tile, rot);
      prep_transpose<2, 256, false>(kparams()->hy_w_uq + (size_t)m * 256 * 768, 256, 768, WSP(bf16_t, WS_WTUQ) + (size_t)m * 768 * 256, 768, tile, rot);
      prep_transpose<0, 128, true>(kparams()->hy_w_ukv + (size_t)m * 128 * 1024, 128, 1024, WSP(bf16_t, WS_WTUKV) + (size_t)m * 1024 * 128, 1024, tile, rot);
      prep_transpose<0, 256, true>(kparams()->hy_w_out + (size_t)m * D * D, D, D, WSP(bf16_t, WS_WTHO) + (size_t)m * D * D, D, tile, rot);
      prep_transpose<0, 256, true>(kparams()->nsa_w_in + (size_t)m * D * NSA_IN, D, NSA_IN, WSP(bf16_t, WS_WTNI) + (size_t)m * 2048 * D, 2048, tile, rot);
      prep_transpose<0, 256, true>(kparams()->nsa_w_out + (size_t)m * D * D, D, D, WSP(bf16_t, WS_WTNO) + (size_t)m * D * D, D, tile, rot);
      for (int kind = 0; kind < 2; ++kind)
        prep_transpose<0, 256, true>(kparams()->nsa_cmp_w1 + (size_t)(m * 2 + kind) * 2048 * 128, 2048, 128, WSP(bf16_t, WS_WTC1) + (size_t)(m * 2 + kind) * 256 * 2048, 256, tile, rot);
    }
    }
    prep_adaln(kparams()->c, kparams()->ada_w, kparams()->ada_b, WSP(float, WS_MOD), tile);
    prep_misc(kparams()->positions, kparams()->nsa_cmp_pe, kparams()->nsa_cmp_w1, WSP(float, WS_ROPE), WSP(float, WS_ROPE) + (size_t)T * 16, WSP(float, WS_CBIAS), tile);
  }
  grid.sync();

  for (int l = 0; l < NLAYER; ++l) {
    const int mi = l >> 1;
    for (int sub = 0; sub < 3; ++sub) {
      const bool first = (l == 0 && sub == 0);
      REP(1) if (PH(1)) { const float* xin = first ? kparams()->x : WSP(float, WS_X);
        norm_phase<0>(xin, kparams()->norm_g + (size_t)(l * 3 + sub) * D, MODL(l) + (3 * sub) * D, MODL(l) + (3 * sub + 1) * D, WSP(bf16_t, WS_HB), nullptr); }
      GSYNC();
      if (sub != 1) {
        const int f = l * 2 + (sub >> 1);
        REP(2) if (PH(2)) { EpiSwiglu E{WSP(bf16_t, WS_UB)}; run_gemm(lds, WSP(bf16_t, WS_HB), D, WSP(bf16_t, WS_WT13) + (size_t)f * 2 * DFF * D, T, 2 * DFF, D, E); }
        GSYNC();
        REP(3) if (PH(3)) { const float* xin = first ? kparams()->x : WSP(float, WS_X);
          EpiResid E{xin, (r_ == (int)((DBLMASK >> 3) & 1u)) ? WSP(float, WS_X) : WSP(float, WS_YF), MODL(l) + (3 * sub + 2) * D, 0.5f}; run_gemm(lds, WSP(bf16_t, WS_UB), DFF, WSP(bf16_t, WS_WT2) + (size_t)f * D * DFF, T, D, DFF, E); }
        GSYNC();
      } else if ((l & 1) == 0) {
        REP(4) if (PH(4)) { EpiPlain E{WSP(bf16_t, WS_Z), 2048}; run_gemm(lds, WSP(bf16_t, WS_HB), D, WSP(bf16_t, WS_WTHI) + (size_t)mi * 2048 * D, T, 2048, D, E); }
        GSYNC();
        REP(5) if (PH(5)) mla_prep_phase(WSP(bf16_t, WS_Z), kparams()->hy_conv_w + (size_t)mi * 3 * 512, kparams()->hy_q_norm + mi * 256, kparams()->hy_kv_norm + mi * 128,
                                  WSP(float, WS_ROPE), WSP(float, WS_ROPE) + (size_t)T * 16, WSP(bf16_t, WS_YB), WSP(bf16_t, WS_CQ), WSP(bf16_t, WS_CKV), WSP(bf16_t, WS_KB));
        GSYNC();
        REP(6) if (PH(6)) { EpiQRope E{WSP(bf16_t, WS_QB), WSP(float, WS_ROPE), WSP(float, WS_ROPE) + (size_t)T * 16, 0.10206207261596575f * LOG2E};
          run_gemm(lds, WSP(bf16_t, WS_CQ), 256, WSP(bf16_t, WS_WTUQ) + (size_t)mi * 768 * 256, T, 768, 256, E); }
        REP(7) if (PH(7)) { EpiMlaKV E{WSP(bf16_t, WS_KB), WSP(bf16_t, WS_VT)}; run_gemm(lds, WSP(bf16_t, WS_CKV), 128, WSP(bf16_t, WS_WTUKV) + (size_t)mi * 1024 * 128, T, 1024, 128, E); }
        GSYNC();
        REP(8) if (PH(8)) mla_attn_phase(WSP(bf16_t, WS_QB), WSP(bf16_t, WS_KB), WSP(bf16_t, WS_VT), WSP(bf16_t, WS_YB), lds);
        GSYNC();
        REP(9) if (PH(9)) { EpiResid E{WSP(float, WS_X), (r_ == (int)((DBLMASK >> 9) & 1u)) ? WSP(float, WS_X) : WSP(float, WS_YF), MODL(l) + 5 * D, 1.0f}; run_gemm(lds, WSP(bf16_t, WS_YB), D, WSP(bf16_t, WS_WTHO) + (size_t)mi * D * D, T, D, D, E); }
        GSYNC();
      } else {
        REP(10) if (PH(10)) { EpiNsaIn E{WSP(bf16_t, WS_QB), WSP(bf16_t, WS_KVC), WSP(bf16_t, WS_KS), WSP(bf16_t, WS_VTS), WSP(bf16_t, WS_KW), WSP(bf16_t, WS_VTW), WSP(float, WS_GT),
                                 kparams()->nsa_gate_b + mi * 48, 0.125f * LOG2E};
          run_gemm(lds, WSP(bf16_t, WS_HB), D, WSP(bf16_t, WS_WTNI) + (size_t)mi * 2048 * D, T, 2048, D, E); }
        GSYNC();
        REP(11) if (PH(11)) for (int kc = 0; kc < 16; ++kc) {
          const int kind = kc >> 3, ch = kc & 7;
          EpiCmp E{WSP(float, WS_CH) + (size_t)kc * 2048 * 128};
          run_gemm(lds, WSP(bf16_t, WS_KVC) + (size_t)kind * T * 128 + ch * 256, 1024, WSP(bf16_t, WS_WTC1) + (size_t)(mi * 2 + kind) * 256 * 2048 + ch * 256, 2048, 256, 256, E, kc * 8, 2048);
        }
        GSYNC();
        REP(12) if (PH(12)) nsa_cmp2_phase(WSP(float, WS_CH), WSP(float, WS_CBIAS) + mi * 2 * 16 * 128, kparams()->nsa_cmp_w2 + (size_t)mi * 2 * 128 * 64, WSP(bf16_t, WS_KC), WSP(bf16_t, WS_VTC), (LAS float*)lds);
        GSYNC();
#ifndef NSA_PAIR
#define NSA_PAIR 1
#endif
        REP(13) if (PH(13)) { if (NSA_PAIR) nsa_attn_phase2(kparams()->ws, lds); else nsa_attn_phase(kparams()->ws, lds); }
        GSYNC();
        REP(14) if (PH(14)) { EpiResid E{WSP(float, WS_X), (r_ == (int)((DBLMASK >> 14) & 1u)) ? WSP(float, WS_X) : WSP(float, WS_YF), MODL(l) + 5 * D, 1.0f}; run_gemm(lds, WSP(bf16_t, WS_YB), D, WSP(bf16_t, WS_WTNO) + (size_t)mi * D * D, T, D, D, E); }
        GSYNC();
      }
    }
  }
  for (int e_ = 0; e_ < EXTRA_SYNCS; ++e_) GSYNC();
  if (PH(15)) norm_phase<1>(WSP(float, WS_X), kparams()->final_g, nullptr, nullptr, nullptr, kparams()->out);
}

extern "C" void kernel_launch(void* const* d_in, const int* in_sizes, int n_in, void* d_out, int out_size, void* d_ws, size_t ws_size, hipStream_t stream) {
  static int grid = 0;
  if (grid == 0) {
    int dev = 0, cus = 0, per_cu = 0;
    if (hipGetDevice(&dev) != hipSuccess || hipDeviceGetAttribute(&cus, hipDeviceAttributeMultiprocessorCount, dev) != hipSuccess) { fprintf(stderr, "device query failed\n"); grid = -1; return; }
    if (hipFuncSetAttribute((const void*)mega, hipFuncAttributeMaxDynamicSharedMemorySize, LDS_BYTES) != hipSuccess) { fprintf(stderr, "hipFuncSetAttribute failed\n"); grid = -1; return; }
    if (hipOccupancyMaxActiveBlocksPerMultiprocessor(&per_cu, (const void*)mega, 512, LDS_BYTES) != hipSuccess || per_cu < 1) { fprintf(stderr, "occupancy query: %d\n", per_cu); }
    (void)hipGetLastError();
    if (ws_size < WS_END) { fprintf(stderr, "workspace too small: %zu < %zu\n", ws_size, (size_t)WS_END); grid = -1; return; }
    grid = cus;
  }
  if (grid < 0) return;
  (void)hipMemsetAsync((char*)d_ws + WS_MOD, 0, ZERO_BYTES, stream);
  Params p{};
  p.x = (const float*)d_in[0]; p.c = (const float*)d_in[1]; p.positions = (const int*)d_in[2]; p.ada_w = (const float*)d_in[3]; p.ada_b = (const float*)d_in[4];
  p.norm_g = (const float*)d_in[5]; p.final_g = (const float*)d_in[6]; p.ff_w13 = (const float*)d_in[7]; p.ff_w2 = (const float*)d_in[8]; p.hy_w_in = (const float*)d_in[9];
  p.hy_conv_w = (const float*)d_in[10]; p.hy_q_norm = (const float*)d_in[11]; p.hy_kv_norm = (const float*)d_in[12]; p.hy_w_uq = (const float*)d_in[13];
  p.hy_w_ukv = (const float*)d_in[14]; p.hy_w_out = (const float*)d_in[15]; p.nsa_w_in = (const float*)d_in[16]; p.nsa_cmp_pe = (const float*)d_in[17];
  p.nsa_cmp_w1 = (const float*)d_in[18]; p.nsa_cmp_w2 = (const float*)d_in[19]; p.nsa_gate_b = (const float*)d_in[20]; p.nsa_w_out = (const float*)d_in[21];
  p.out = (float*)d_out; p.ws = (unsigned char*)d_ws;
  void* args[] = {&p};
  hipError_t e = hipLaunchCooperativeKernel((const void*)mega, dim3(grid), dim3(512), args, LDS_BYTES, stream);
  if (e != hipSuccess) fprintf(stderr, "cooperative launch failed: %s (grid %d)\n", hipGetErrorString(e), grid);
}
```
